# Optimizing an MI355X kernel written in HIP

```python
import jax, jax.numpy as jnp
from jax import lax
import numpy as np

D_MODEL = 1024
BATCH = 16
SEQ = 2048
DEPTH = 2
DEC_BATCH = 32
DEC_SEQ = 64
PAST_LEN = 2048

N_HEADS = 16
HEAD_DIM = D_MODEL // N_HEADS
CHUNK = 64
LEFT_CHUNKS = 8
BAND = (LEFT_CHUNKS + 1) * CHUNK
A_CACHE_ROWS = LEFT_CHUNKS * CHUNK
REL_CLIP = 128
N_REL = 2 * REL_CLIP + 1
SB_BLOCK = 128
N_A_LAYERS = DEPTH // 2
N_B_LAYERS = DEPTH - N_A_LAYERS
RMS_EPS = 1e-6
NEG_INF = -1e30
SCALE = HEAD_DIM ** -0.5

kernel_name = 'yoco_chunkband_stickbreaking_step'


def rms_norm(x, g):
    xf = x.astype(jnp.float32)
    y = xf * lax.rsqrt(jnp.mean(xf * xf, axis=-1, keepdims=True) + RMS_EPS)
    return (y * g.astype(jnp.float32)).astype(x.dtype)


def split_heads(t):
    return t.reshape(*t.shape[:-1], N_HEADS, HEAD_DIM)


def gated_out(o, gate, w_out):
    b, t = o.shape[:2]
    return (o.reshape(b, t, D_MODEL) * jax.nn.silu(gate)) @ w_out


def a_project(x, g, w_in):
    h = rms_norm(x, g)
    q, k, v, gate = jnp.split(h @ w_in, 4, axis=-1)
    return split_heads(q), split_heads(k), split_heads(v), gate


def b_project(x, g, w_in):
    h = rms_norm(x, g)
    q, gate = jnp.split(h @ w_in, 2, axis=-1)
    return split_heads(q), gate


def shared_kv(x, g, w_kv):
    h = rms_norm(x, g)
    k, v = jnp.split(h @ w_kv, 2, axis=-1)
    return split_heads(k), split_heads(v)


def band_attend(q, k, v, q_pos, k_pos, rel_bias):
    s = jnp.einsum('bqhd,bkhd->bhqk', q, k).astype(jnp.float32) * SCALE
    rel = jnp.clip(q_pos[:, None] - k_pos[None, :], -REL_CLIP, REL_CLIP) + REL_CLIP
    s = s + rel_bias[:, rel].astype(jnp.float32)[None]
    qc = q_pos // CHUNK
    kc = k_pos // CHUNK
    mask = ((k_pos[None, :] >= 0) & (kc[None, :] <= qc[:, None])
            & (kc[None, :] >= qc[:, None] - LEFT_CHUNKS))
    s = jnp.where(mask[None, None], s, NEG_INF)
    p = jax.nn.softmax(s, axis=-1).astype(v.dtype)
    return jnp.einsum('bhqk,bkhd->bqhd', p, v)


def chunk_band_prompt(q, k, v, rel_bias):
    b, t, h, dh = q.shape
    n_chunks = t // CHUNK
    pad = A_CACHE_ROWS
    kp = jnp.pad(k, ((0, 0), (pad, 0), (0, 0), (0, 0)))
    vp = jnp.pad(v, ((0, 0), (pad, 0), (0, 0), (0, 0)))
    qc = q.reshape(b, n_chunks, CHUNK, h, dh).transpose(1, 0, 2, 3, 4)

    def one_chunk(args):
        c, qb = args
        start = c * CHUNK
        kb = lax.dynamic_slice_in_dim(kp, start, BAND, axis=1)
        vb = lax.dynamic_slice_in_dim(vp, start, BAND, axis=1)
        q_pos = start + jnp.arange(CHUNK, dtype=jnp.int32)
        k_pos = start - pad + jnp.arange(BAND, dtype=jnp.int32)
        return band_attend(qb, kb, vb, q_pos, k_pos, rel_bias)

    out = lax.map(one_chunk, (jnp.arange(n_chunks, dtype=jnp.int32), qc))
    return out.transpose(1, 0, 2, 3, 4).reshape(b, t, h, dh)


def sb_block(q, k, v, q_pos, k_pos):
    z = jnp.einsum('bqhd,bkhd->bhqk', q, k).astype(jnp.float32) * SCALE
    mask = (k_pos[None, :] < q_pos[:, None])[None, None]
    log_fail = jnp.where(mask, jax.nn.log_sigmoid(-z), 0.0)
    later = jnp.flip(jnp.cumsum(jnp.flip(log_fail, -1), axis=-1), -1) - log_fail
    w = jnp.where(mask, jnp.exp(jax.nn.log_sigmoid(z) + later), 0.0)
    return jnp.einsum('bhqk,bkhd->bqhd', w.astype(v.dtype), v)


def sb_prompt(q, k, v):
    t = q.shape[1]
    pos = jnp.arange(t, dtype=jnp.int32)
    outs = []
    for start in range(0, t, SB_BLOCK):
        end = start + SB_BLOCK
        outs.append(sb_block(q[:, start:end], k[:, :end], v[:, :end], pos[start:end], pos[:end]))
    return jnp.concatenate(outs, axis=1)


def setup_inputs(seed: int = 0) -> dict:
    key = jax.random.key(seed)
    ks = jax.random.split(key, 16)
    d = D_MODEL
    a_rows = min(A_CACHE_ROWS, PAST_LEN)
    nrm = jax.random.normal
    return {
        'x_prompt': nrm(ks[0], (BATCH, SEQ, d), jnp.float32),
        'x_sample': nrm(ks[1], (DEC_BATCH, DEC_SEQ, d), jnp.float32),
        'cache_a_k': nrm(ks[2], (N_A_LAYERS, DEC_BATCH, a_rows, N_HEADS, HEAD_DIM), jnp.float32),
        'cache_a_v': nrm(ks[3], (N_A_LAYERS, DEC_BATCH, a_rows, N_HEADS, HEAD_DIM), jnp.float32),
        'cache_b_k': nrm(ks[4], (DEC_BATCH, PAST_LEN, N_HEADS, HEAD_DIM), jnp.float32),
        'cache_b_v': nrm(ks[5], (DEC_BATCH, PAST_LEN, N_HEADS, HEAD_DIM), jnp.float32),
        'norm_a': 1.0 + 0.02 * nrm(ks[6], (N_A_LAYERS, d), jnp.float32),
        'w_in_a': nrm(ks[7], (N_A_LAYERS, d, 4 * d), jnp.float32) * d ** -0.5,
        'rel_bias_a': 0.1 * nrm(ks[8], (N_A_LAYERS, N_HEADS, N_REL), jnp.float32),
        'w_out_a': nrm(ks[9], (N_A_LAYERS, d, d), jnp.float32) * d ** -0.5,
        'norm_kv': 1.0 + 0.02 * nrm(ks[10], (d,), jnp.float32),
        'w_kv': nrm(ks[11], (d, 2 * d), jnp.float32) * d ** -0.5,
        'norm_b': 1.0 + 0.02 * nrm(ks[12], (N_B_LAYERS, d), jnp.float32),
        'w_in_b': nrm(ks[13], (N_B_LAYERS, d, 2 * d), jnp.float32) * d ** -0.5,
        'w_out_b': nrm(ks[14], (N_B_LAYERS, d, d), jnp.float32) * d ** -0.5,
        'norm_f': 1.0 + 0.02 * nrm(ks[15], (d,), jnp.float32),
    }


def reference(x_prompt, x_sample, cache_a_k, cache_a_v, cache_b_k, cache_b_v,
              norm_a, w_in_a, rel_bias_a, w_out_a, norm_kv, w_kv,
              norm_b, w_in_b, w_out_b, norm_f):
    past_len = cache_b_k.shape[1]
    ts = x_sample.shape[1]
    a_rows = cache_a_k.shape[2]
    q_pos_s = past_len + jnp.arange(ts, dtype=jnp.int32)
    k_pos_a = past_len - a_rows + jnp.arange(a_rows + ts, dtype=jnp.int32)
    k_pos_b = jnp.arange(past_len + ts, dtype=jnp.int32)

    xp, xs = x_prompt, x_sample
    a_kp, a_vp, a_ks, a_vs = [], [], [], []
    for layer in range(DEPTH):
        if layer < N_A_LAYERS:
            i = layer
            qp, kp, vp, gp = a_project(xp, norm_a[i], w_in_a[i])
            qs, ks, vs, gs = a_project(xs, norm_a[i], w_in_a[i])
            op = chunk_band_prompt(qp, kp, vp, rel_bias_a[i])
            k_all = jnp.concatenate([cache_a_k[i], ks], axis=1)
            v_all = jnp.concatenate([cache_a_v[i], vs], axis=1)
            o_s = band_attend(qs, k_all, v_all, q_pos_s, k_pos_a, rel_bias_a[i])
            xp = xp + gated_out(op, gp, w_out_a[i])
            xs = xs + gated_out(o_s, gs, w_out_a[i])
            keep = min(A_CACHE_ROWS, xp.shape[1])
            a_kp.append(kp[:, -keep:])
            a_vp.append(vp[:, -keep:])
            a_ks.append(ks)
            a_vs.append(vs)
        else:
            if layer == N_A_LAYERS:
                kb_p, vb_p = shared_kv(xp, norm_kv, w_kv)
                kb_s, vb_s = shared_kv(xs, norm_kv, w_kv)
                kb_all = jnp.concatenate([cache_b_k, kb_s], axis=1)
                vb_all = jnp.concatenate([cache_b_v, vb_s], axis=1)
            j = layer - N_A_LAYERS
            qp, gp = b_project(xp, norm_b[j], w_in_b[j])
            qs, gs = b_project(xs, norm_b[j], w_in_b[j])
            op = sb_prompt(qp, kb_p, vb_p)
            o_s = sb_block(qs, kb_all, vb_all, q_pos_s, k_pos_b)
            xp = xp + gated_out(op, gp, w_out_b[j])
            xs = xs + gated_out(o_s, gs, w_out_b[j])

    y_prompt = rms_norm(xp, norm_f)
    y_sample = rms_norm(xs, norm_f)
    new_a_k_prompt = jnp.stack(a_kp)
    new_a_v_prompt = jnp.stack(a_vp)
    new_a_k_sample = jnp.stack(a_ks)
    new_a_v_sample = jnp.stack(a_vs)
    return (y_prompt, y_sample, new_a_k_prompt, new_a_v_prompt, kb_p, vb_p,
            new_a_k_sample, new_a_v_sample, kb_s, vb_s)
```

```cpp
#include <hip/hip_runtime.h>
#include <hip/hip_cooperative_groups.h>
#include <cstdio>
namespace cg = cooperative_groups;

#ifndef ONE_LAUNCH
#define ONE_LAUNCH 0
#endif

typedef __bf16 bf16;
typedef __bf16 bf16x2 __attribute__((ext_vector_type(2)));
typedef __bf16 bf16x4 __attribute__((ext_vector_type(4)));
typedef __bf16 bf16x8 __attribute__((ext_vector_type(8)));
typedef float f32x2 __attribute__((ext_vector_type(2)));
typedef float f32x4 __attribute__((ext_vector_type(4)));
typedef float f32x16 __attribute__((ext_vector_type(16)));
typedef unsigned u32x2 __attribute__((ext_vector_type(2)));
typedef unsigned u32x4 __attribute__((ext_vector_type(4)));
typedef __attribute__((address_space(3))) bf16x4 lds_bf16x4;

#define DI __device__ __forceinline__
#define MFMA(a, b, c) __builtin_amdgcn_mfma_f32_32x32x16_bf16((a), (b), (c), 0, 0, 0)

constexpr int TP = 32768;
constexpr int MT = 34816;
constexpr float LOG2E = 1.4426950408889634f;
constexpr float QSCALE = 0.125f * LOG2E;
constexpr float EPS = 1e-6f;

constexpr size_t OFF_AKP = 35651584, OFF_AVP = 44040192, OFF_KBP = 52428800, OFF_VBP = 85983232;
constexpr size_t OFF_AKS = 119537664, OFF_AVS = 121634816, OFF_KBS = 123731968, OFF_VBS = 125829120;
constexpr size_t WS_WA = 0, WS_WOA = 8388608, WS_WB = 10485760, WS_WOB = 18874368, WS_XB = 20971520;
constexpr size_t WS_QKVG = 92274688, WS_AO = 377487360, WS_X1 = 448790528, WS_SS0 = 591396864;
constexpr size_t WS_SS1 = 591536128, WS_SS2 = 593764352;

constexpr int SMEM_BYTES = 78848;
constexpr int KROW = 272, VROW = 320;
constexpr int KV_BUF = 64 * KROW + 64 * VROW;
constexpr int BIAS_OFF = 2 * KV_BUF;

struct Params {
  const float *x_prompt, *x_sample, *cache_a_k, *cache_a_v, *cache_b_k, *cache_b_v;
  const float *norm_a, *w_in_a, *rel_bias_a, *w_out_a, *norm_kv, *w_kv, *norm_b, *w_in_b, *w_out_b, *norm_f;
  float* out;
  bf16 *Wa, *Woa, *Wb, *Wob, *xb, *qkvg, *ao;
  float *x1, *ss0, *ss1, *ss2;
};

DI unsigned pk(float a, float b) { f32x2 v = {a, b}; return __builtin_bit_cast(unsigned, __builtin_convertvector(v, bf16x2)); }
DI float bf_lo(unsigned u) { return __uint_as_float(u << 16); }
DI float bf_hi(unsigned u) { return __uint_as_float(u & 0xffff0000u); }
DI float silu(float x) { return x * __builtin_amdgcn_rcpf(1.f + __builtin_amdgcn_exp2f(-x * LOG2E)); }
DI int tid() { int t = threadIdx.x; asm volatile("" : "+v"(t)); return t; }
DI int pi_swap(int m) { return (m & ~12) | ((m & 4) << 1) | ((m & 8) >> 1); }

DI void prep_wtile(const Params& p, int item, char* smem) {
  float* lds = (float*)smem;
  const float* W; const float* g; bf16* Wt; int N, local;
  if (item < 1024)      { W = p.w_in_a;  N = 4096; g = p.norm_a;  Wt = p.Wa;  local = item; }
  else if (item < 1280) { W = p.w_out_a; N = 1024; g = nullptr;   Wt = p.Woa; local = item - 1024; }
  else if (item < 1792) { W = p.w_kv;    N = 2048; g = p.norm_kv; Wt = p.Wb;  local = item - 1280; }
  else if (item < 2304) { W = p.w_in_b;  N = 2048; g = p.norm_b;  Wt = p.Wb + (size_t)2048 * 1024; local = item - 1792; }
  else                  { W = p.w_out_b; N = 1024; g = nullptr;   Wt = p.Wob; local = item - 2304; }
  const int ntn = N >> 6, kt = local / ntn, nt = local % ntn, t = tid();
#pragma unroll
  for (int pass = 0; pass < 4; ++pass) {
    const int r = (t >> 4) + 16 * pass, c4 = (t & 15) * 4;
    f32x4 v = *(const f32x4*)(W + (size_t)(kt * 64 + r) * N + nt * 64 + c4);
    const float gg = g ? g[kt * 64 + r] : 1.f;
    lds[r * 65 + c4 + 0] = v.x * gg; lds[r * 65 + c4 + 1] = v.y * gg;
    lds[r * 65 + c4 + 2] = v.z * gg; lds[r * 65 + c4 + 3] = v.w * gg;
  }
  __syncthreads();
#pragma unroll
  for (int it = 0; it < 2; ++it) {
    const int n = t >> 2, kg = (t & 3) + 4 * it;
    u32x4 o;
    o.x = pk(lds[(8 * kg + 0) * 65 + n], lds[(8 * kg + 1) * 65 + n]);
    o.y = pk(lds[(8 * kg + 2) * 65 + n], lds[(8 * kg + 3) * 65 + n]);
    o.z = pk(lds[(8 * kg + 4) * 65 + n], lds[(8 * kg + 5) * 65 + n]);
    o.w = pk(lds[(8 * kg + 6) * 65 + n], lds[(8 * kg + 7) * 65 + n]);
    *(u32x4*)(Wt + (size_t)(nt * 64 + n) * 1024 + kt * 64 + 8 * kg) = o;
  }
  __syncthreads();
}

DI const float* xrow(const Params& p, int row) {
  return row < TP ? p.x_prompt + (size_t)row * 1024 : p.x_sample + (size_t)(row - TP) * 1024;
}

DI void prep_xrows(const Params& p, int item) {
  const int t_ = tid(), lane = t_ & 63, w = t_ >> 6, row = item * 4 + w;
  const float* x = xrow(p, row);
  float ss = 0.f;
#pragma unroll
  for (int i = 0; i < 4; ++i) {
    f32x4 v = *(const f32x4*)(x + (i * 64 + lane) * 4);
    ss += v.x * v.x + v.y * v.y + v.z * v.z + v.w * v.w;
    u32x2 o = {pk(v.x, v.y), pk(v.z, v.w)};
    *(u32x2*)(p.xb + (size_t)row * 1024 + (i * 64 + lane) * 4) = o;
  }
#pragma unroll
  for (int m = 32; m >= 1; m >>= 1) ss += __shfl_xor(ss, m);
  if (lane == 0) p.ss0[row] = ss;
}

template <int MODE>
DI void gemm_tile(const Params& p, int tile, char* smem) {
  constexpr int NT = (MODE == 1 || MODE == 3) ? 32 : 8;
  const int tm = tile / NT, tn = tile % NT;
  const bf16* A = (MODE == 1 || MODE == 3) ? p.xb : p.ao;
  const bf16* W = MODE == 1 ? p.Wa : MODE == 2 ? p.Woa : MODE == 3 ? p.Wb : p.Wob;
  const int t = tid(), lane = t & 63, w = t >> 6, wm = w & 1, wn = w >> 1, l32 = lane & 31, h = lane >> 5;
  const bf16* Ag = A + (size_t)(tm * 128 + (t >> 3)) * 1024 + (t & 7) * 8;
  const bf16* Wg = W + (size_t)(tn * 128 + (t >> 3)) * 1024 + (t & 7) * 8;
  const int st_off = ((t >> 3) * 72 + (t & 7) * 8) * 2;
  u32x4 ra[4], rw[4];
  f32x16 acc[2][2];
#pragma unroll
  for (int a = 0; a < 2; ++a)
#pragma unroll
    for (int b = 0; b < 2; ++b)
#pragma unroll
      for (int i = 0; i < 16; ++i) acc[a][b][i] = 0.f;

#pragma unroll
  for (int i = 0; i < 4; ++i) { ra[i] = *(const u32x4*)(Ag + (size_t)(32 * i) * 1024); rw[i] = *(const u32x4*)(Wg + (size_t)(32 * i) * 1024); }
#pragma unroll
  for (int i = 0; i < 4; ++i) { *(u32x4*)(smem + st_off + i * 32 * 144) = ra[i]; *(u32x4*)(smem + 36864 + st_off + i * 32 * 144) = rw[i]; }
  __syncthreads();
  const int xo = ((wm * 64 + l32) * 72 + 8 * h) * 2, wo = 36864 + ((wn * 64 + l32) * 72 + 8 * h) * 2;
  for (int kt = 0; kt < 16; ++kt) {
    if (kt < 15) {
#pragma unroll
      for (int i = 0; i < 4; ++i) {
        ra[i] = *(const u32x4*)(Ag + (size_t)(32 * i) * 1024 + (kt + 1) * 64);
        rw[i] = *(const u32x4*)(Wg + (size_t)(32 * i) * 1024 + (kt + 1) * 64);
      }
    }
    const char* base = smem + (kt & 1) * 18432;
#pragma unroll
    for (int s = 0; s < 4; ++s) {
      bf16x8 wf0 = *(const bf16x8*)(base + wo + s * 32);
      bf16x8 wf1 = *(const bf16x8*)(base + wo + 32 * 144 + s * 32);
      bf16x8 xf0 = *(const bf16x8*)(base + xo + s * 32);
      bf16x8 xf1 = *(const bf16x8*)(base + xo + 32 * 144 + s * 32);
      acc[0][0] = MFMA(wf0, xf0, acc[0][0]);
      acc[0][1] = MFMA(wf0, xf1, acc[0][1]);
      acc[1][0] = MFMA(wf1, xf0, acc[1][0]);
      acc[1][1] = MFMA(wf1, xf1, acc[1][1]);
    }
    if (kt < 15) {
      char* nb = smem + ((kt + 1) & 1) * 18432;
#pragma unroll
      for (int i = 0; i < 4; ++i) { *(u32x4*)(nb + st_off + i * 32 * 144) = ra[i]; *(u32x4*)(nb + 36864 + st_off + i * 32 * 144) = rw[i]; }
    }
    __syncthreads();
  }

#pragma unroll
  for (int tj = 0; tj < 2; ++tj) {
    const int tok = tm * 128 + wm * 64 + tj * 32 + l32;
    float rstd = 1.f;
    if (MODE == 1) rstd = __builtin_amdgcn_rsqf(p.ss0[tok] * (1.f / 1024.f) + EPS);
    if (MODE == 3) {
      const f32x4* s4 = (const f32x4*)(p.ss1 + (size_t)tok * 16);
      f32x4 a = s4[0], b = s4[1], c = s4[2], d = s4[3];
      float s = ((a.x + a.y) + (a.z + a.w)) + ((b.x + b.y) + (b.z + b.w)) + ((c.x + c.y) + (c.z + c.w)) + ((d.x + d.y) + (d.z + d.w));
      rstd = __builtin_amdgcn_rsqf(s * (1.f / 1024.f) + EPS);
    }
    float ssq = 0.f;
#pragma unroll
    for (int fi = 0; fi < 2; ++fi) {
#pragma unroll
      for (int g = 0; g < 4; ++g) {
        const int col = tn * 128 + wn * 64 + fi * 32 + 8 * g + 4 * h;
        float v0 = acc[fi][tj][4 * g + 0], v1 = acc[fi][tj][4 * g + 1], v2 = acc[fi][tj][4 * g + 2], v3 = acc[fi][tj][4 * g + 3];
        if (MODE == 1 || MODE == 3) {
          v0 *= rstd; v1 *= rstd; v2 *= rstd; v3 *= rstd;
          const int type = tn >> 3;
          constexpr int QT = (MODE == 1) ? 0 : 2;
          if (type == QT) { v0 *= QSCALE; v1 *= QSCALE; v2 *= QSCALE; v3 *= QSCALE; }
          else if (type == 3) { v0 = silu(v0); v1 = silu(v1); v2 = silu(v2); v3 = silu(v3); }
          else {
            f32x4 fv = {v0, v1, v2, v3};
            const int c = col & 1023;
            if (MODE == 1) {
              const size_t offp = (type == 1) ? OFF_AKP : OFF_AVP, offs = (type == 1) ? OFF_AKS : OFF_AVS;
              if (tok < TP) {
                const int tt = tok & 2047;
                if (tt >= 1536) *(f32x4*)(p.out + offp + ((size_t)((tok >> 11) * 512 + tt - 1536)) * 1024 + c) = fv;
              } else {
                *(f32x4*)(p.out + offs + (size_t)(tok - TP) * 1024 + c) = fv;
              }
            } else {
              const size_t offp = (type == 0) ? OFF_KBP : OFF_VBP, offs = (type == 0) ? OFF_KBS : OFF_VBS;
              if (tok < TP) *(f32x4*)(p.out + offp + (size_t)tok * 1024 + c) = fv;
              else *(f32x4*)(p.out + offs + (size_t)(tok - TP) * 1024 + c) = fv;
            }
          }
          u32x2 o = {pk(v0, v1), pk(v2, v3)};
          *(u32x2*)(p.qkvg + (size_t)tok * 4096 + col) = o;
        } else {
          const float* res = (MODE == 2) ? xrow(p, tok) : p.x1 + (size_t)tok * 1024;
          f32x4 r = *(const f32x4*)(res + col);
          f32x4 y = {r.x + v0, r.y + v1, r.z + v2, r.w + v3};
          ssq += y.x * y.x + y.y * y.y + y.z * y.z + y.w * y.w;
          if (MODE == 2) {
            *(f32x4*)(p.x1 + (size_t)tok * 1024 + col) = y;
            u32x2 o = {pk(y.x, y.y), pk(y.z, y.w)};
            *(u32x2*)(p.xb + (size_t)tok * 1024 + col) = o;
          } else {
            *(f32x4*)(p.out + (size_t)tok * 1024 + col) = y;
          }
        }
      }
    }
    if (MODE == 2 || MODE == 4) {
      ssq += __shfl_xor(ssq, 32);
      float* ssd = (MODE == 2) ? p.ss1 : p.ss2;
      if (h == 0) ssd[(size_t)tok * 16 + tn * 2 + wn] = ssq;
    }
  }
}

DI void kv_load_bf16(const bf16* kb, const bf16* vb, u32x4* stg, int t) {
#pragma unroll
  for (int i = 0; i < 4; ++i) stg[i] = *(const u32x4*)(kb + (size_t)((t >> 4) + 16 * i) * 4096 + (t & 15) * 8);
#pragma unroll
  for (int i = 0; i < 4; ++i) stg[4 + i] = *(const u32x4*)(vb + (size_t)((t >> 4) + 16 * i) * 4096 + (t & 15) * 8);
}
DI void kv_store_bf16(char* Ks, const u32x4* stg, int t) {
  char* Vs = Ks + 64 * KROW;
#pragma unroll
  for (int i = 0; i < 4; ++i) *(u32x4*)(Ks + ((t >> 4) + 16 * i) * KROW + (t & 15) * 16) = stg[i];
#pragma unroll
  for (int i = 0; i < 4; ++i) *(u32x4*)(Vs + ((t >> 4) + 16 * i) * VROW + (t & 15) * 16) = stg[4 + i];
}
DI void kv_load_f32(const float* kf, const float* vf, u32x4* stg, int t) {
#pragma unroll
  for (int i = 0; i < 4; ++i) {
    const float* a = kf + (size_t)((t >> 4) + 16 * i) * 1024 + (t & 15) * 8;
    f32x4 v0 = *(const f32x4*)a, v1 = *(const f32x4*)(a + 4);
    u32x4 o = {pk(v0.x, v0.y), pk(v0.z, v0.w), pk(v1.x, v1.y), pk(v1.z, v1.w)};
    stg[i] = o;
  }
#pragma unroll
  for (int i = 0; i < 4; ++i) {
    const float* a = vf + (size_t)((t >> 4) + 16 * i) * 1024 + (t & 15) * 8;
    f32x4 v0 = *(const f32x4*)a, v1 = *(const f32x4*)(a + 4);
    u32x4 o = {pk(v0.x, v0.y), pk(v0.z, v0.w), pk(v1.x, v1.y), pk(v1.z, v1.w)};
    stg[4 + i] = o;
  }
}

DI void qk_half(const char* Ks, const bf16x8* qf, f32x16& sacc, int st, int hd, int l32, int h) {
  const int prow = pi_swap(l32);
#pragma unroll
  for (int i = 0; i < 16; ++i) sacc[i] = 0.f;
#pragma unroll
  for (int s = 0; s < 4; ++s) {
    bf16x8 kf = *(const bf16x8*)(Ks + (32 * st + prow) * KROW + (hd * 64 + 16 * s + 8 * h) * 2);
    sacc = MFMA(kf, qf[s], sacc);
  }
}
DI void pv_half(const char* Vs, const f32x16& pw, f32x16* oacc, int st, int hd, int lane) {
  const int h = lane >> 5, qd = (lane & 15) >> 2, blk = (lane >> 4) & 1, pp = lane & 3;
  const char* vbase = Vs + (32 * st + 8 * h + qd) * VROW + hd * 128 + blk * 32 + pp * 8;
#pragma unroll
  for (int ss = 0; ss < 2; ++ss) {
    u32x4 pu = {pk(pw[8 * ss + 0], pw[8 * ss + 1]), pk(pw[8 * ss + 2], pw[8 * ss + 3]),
                pk(pw[8 * ss + 4], pw[8 * ss + 5]), pk(pw[8 * ss + 6], pw[8 * ss + 7])};
    bf16x8 pf = __builtin_bit_cast(bf16x8, pu);
#pragma unroll
    for (int dt = 0; dt < 2; ++dt) {
      const char* a = vbase + (16 * ss) * VROW + dt * 64;
      bf16x4 lo = __builtin_amdgcn_ds_read_tr16_b64_v4bf16((lds_bf16x4*)(a));
      bf16x4 hi = __builtin_amdgcn_ds_read_tr16_b64_v4bf16((lds_bf16x4*)(a + 4 * VROW));
      bf16x8 vf = __builtin_shufflevector(lo, hi, 0, 1, 2, 3, 4, 5, 6, 7);
      oacc[dt] = MFMA(vf, pf, oacc[dt]);
    }
  }
}
DI void attn_store(const Params& p, const f32x16* oacc, float scale, int tok, int head, int h) {
#pragma unroll
  for (int dt = 0; dt < 2; ++dt)
#pragma unroll
    for (int g = 0; g < 4; ++g) {
      const int col = head * 64 + dt * 32 + 8 * g + 4 * h;
      u32x2 sg = *(const u32x2*)(p.qkvg + (size_t)tok * 4096 + 3072 + col);
      u32x2 o = {pk(oacc[dt][4 * g + 0] * scale * bf_lo(sg.x), oacc[dt][4 * g + 1] * scale * bf_hi(sg.x)),
                 pk(oacc[dt][4 * g + 2] * scale * bf_lo(sg.y), oacc[dt][4 * g + 3] * scale * bf_hi(sg.y))};
      *(u32x2*)(p.ao + (size_t)tok * 1024 + col) = o;
    }
}

DI void band_item(const Params& p, int item, char* smem) {
  const int t = tid(), lane = t & 63, w = t >> 6, hd = w >> 1, qsub = w & 1, l32 = lane & 31, h = lane >> 5;
  int hp, b, c, qrow0, ntiles;
  const bool sample = item >= 4096;
  if (!sample) { hp = item & 7; c = (item >> 3) & 31; b = item >> 8; qrow0 = b * 2048 + c * 64; ntiles = (c < 8 ? c : 8) + 1; }
  else { const int it = item - 4096; hp = it & 7; b = it >> 3; c = 8; qrow0 = TP + b * 64; ntiles = 9; }
  const int head = hp * 2 + hd;
  const int tok = qrow0 + qsub * 32 + l32;
  float* bias = (float*)(smem + BIAS_OFF);
  for (int i = t; i < 2 * 257; i += 256) {
    const int hh = i / 257, r = i % 257;
    bias[hh * 260 + r] = p.rel_bias_a[(hp * 2 + hh) * 257 + r] * LOG2E;
  }
  bf16x8 qf[4];
#pragma unroll
  for (int s = 0; s < 4; ++s) qf[s] = *(const bf16x8*)(p.qkvg + (size_t)tok * 4096 + head * 64 + 16 * s + 8 * h);

  u32x4 stg[8];
  const int j0 = c + 1 - ntiles;
  auto load_tile = [&](int j) {
    if (!sample) {
      const bf16* kb = p.qkvg + (size_t)(b * 2048 + j * 64) * 4096 + 1024 + hp * 128;
      kv_load_bf16(kb, kb + 1024, stg, t);
    } else if (j < 8) {
      const size_t o = (size_t)(b * 512 + j * 64) * 1024 + hp * 128;
      kv_load_f32(p.cache_a_k + o, p.cache_a_v + o, stg, t);
    } else {
      const bf16* kb = p.qkvg + (size_t)(TP + b * 64) * 4096 + 1024 + hp * 128;
      kv_load_bf16(kb, kb + 1024, stg, t);
    }
  };
  auto store_tile = [&](int j, char* Ks) {
    kv_store_bf16(Ks, stg, t);
  };
  load_tile(j0); store_tile(j0, smem);
  __syncthreads();

  f32x16 oacc[2];
#pragma unroll
  for (int d = 0; d < 2; ++d)
#pragma unroll
    for (int i = 0; i < 16; ++i) oacc[d][i] = 0.f;
  float m_run = -1e30f, l_run = 0.f;
  const float* bh = bias + hd * 260;

  for (int idx = 0; idx < ntiles; ++idx) {
    const int j = j0 + idx;
    if (idx + 1 < ntiles) load_tile(j + 1);
    const char* Ks = smem + (idx & 1) * KV_BUF;
    const int dj = c - j;
    const float cb = bh[256];
    const int idx0 = dj * 64 + qsub * 32 + l32 - 8 * h;
#pragma unroll
    for (int st = 0; st < 2; ++st) {
      f32x16 sacc;
      qk_half(Ks, qf, sacc, st, hd, l32, h);
      if (dj >= 3) {
#pragma unroll
        for (int i = 0; i < 16; ++i) sacc[i] += cb;
      } else {
#pragma unroll
        for (int i = 0; i < 16; ++i) {
          int r = idx0 - (32 * st + 16 * (i >> 3) + (i & 7));
          r = (r > 128 ? 128 : r) + 128;
          sacc[i] += bh[r];
        }
      }
      float mx = sacc[0];
#pragma unroll
      for (int i = 1; i < 16; ++i) mx = fmaxf(mx, sacc[i]);
      mx = fmaxf(mx, __shfl_xor(mx, 32));
      const float m_new = fmaxf(m_run, mx);
      const float alpha = __builtin_amdgcn_exp2f(m_run - m_new);
      m_run = m_new;
      float ls = 0.f;
#pragma unroll
      for (int i = 0; i < 16; ++i) { const float e = __builtin_amdgcn_exp2f(sacc[i] - m_new); sacc[i] = e; ls += e; }
      l_run = l_run * alpha + ls;
#pragma unroll
      for (int d = 0; d < 2; ++d)
#pragma unroll
        for (int i = 0; i < 16; ++i) oacc[d][i] *= alpha;
      pv_half(Ks + 64 * KROW, sacc, oacc, st, hd, lane);
    }
    if (idx + 1 < ntiles) store_tile(j + 1, smem + ((idx + 1) & 1) * KV_BUF);
    __syncthreads();
  }
  const float l = l_run + __shfl_xor(l_run, 32);
  attn_store(p, oacc, 1.f / l, tok, head, h);
}

DI void sb_item(const Params& p, int item, char* smem) {
  const int t = tid(), lane = t & 63, w = t >> 6, hd = w >> 1, qsub = w & 1, l32 = lane & 31, h = lane >> 5;
  int hp, b, qt, qrow0, ntiles;
  const bool sample = item >= 4096;
  if (!sample) { hp = item & 7; qt = 31 - ((item >> 3) & 31); b = item >> 8; qrow0 = b * 2048 + qt * 64; ntiles = qt + 1; }
  else { const int it = item - 4096; hp = it & 7; b = it >> 3; qt = 32; qrow0 = TP + b * 64; ntiles = 33; }
  const int head = hp * 2 + hd;
  const int tok = qrow0 + qsub * 32 + l32;
  bf16x8 qf[4];
#pragma unroll
  for (int s = 0; s < 4; ++s) qf[s] = *(const bf16x8*)(p.qkvg + (size_t)tok * 4096 + 2048 + head * 64 + 16 * s + 8 * h);

  u32x4 stg[8];
  auto load_tile = [&](int kt) {
    if (!sample) {
      const bf16* kb = p.qkvg + (size_t)(b * 2048 + kt * 64) * 4096 + hp * 128;
      kv_load_bf16(kb, kb + 1024, stg, t);
    } else if (kt == 32) {
      const bf16* kb = p.qkvg + (size_t)(TP + b * 64) * 4096 + hp * 128;
      kv_load_bf16(kb, kb + 1024, stg, t);
    } else {
      const size_t o = (size_t)(b * 2048 + kt * 64) * 1024 + hp * 128;
      kv_load_f32(p.cache_b_k + o, p.cache_b_v + o, stg, t);
    }
  };
  auto store_tile = [&](int kt, char* Ks) {
    kv_store_bf16(Ks, stg, t);
  };
  load_tile(qt); store_tile(qt, smem);
  __syncthreads();

  f32x16 oacc[2];
#pragma unroll
  for (int d = 0; d < 2; ++d)
#pragma unroll
    for (int i = 0; i < 16; ++i) oacc[d][i] = 0.f;
  float carry = 1.f;
  const int qlim = qsub * 32 + l32 - 8 * h;

  for (int idx = 0; idx < ntiles; ++idx) {
    const int kt = qt - idx;
    if (idx + 1 < ntiles) load_tile(kt - 1);
    const char* Ks = smem + (idx & 1) * KV_BUF;
    const bool diag = (idx == 0);
#pragma unroll
    for (int st = 1; st >= 0; --st) {
      f32x16 fz, sg;
      qk_half(Ks, qf, fz, st, hd, l32, h);
#pragma unroll
      for (int i = 0; i < 16; ++i) {
        const float e = __builtin_amdgcn_exp2f(fminf(fz[i], 100.f));
        float f = __builtin_amdgcn_rcpf(1.f + e);
        float sv = e * f;
        if (diag) {
          const bool valid = (32 * st + 16 * (i >> 3) + (i & 7)) < qlim;
          f = valid ? f : 1.f; sv = valid ? sv : 0.f;
        }
        fz[i] = f; sg[i] = sv;
      }
      float T[2], Tp[2];
#pragma unroll
      for (int r = 0; r < 2; ++r) {
        const int o = r * 8;
        T[r] = ((fz[o] * fz[o + 1]) * (fz[o + 2] * fz[o + 3])) * ((fz[o + 4] * fz[o + 5]) * (fz[o + 6] * fz[o + 7]));
        Tp[r] = __shfl_xor(T[r], 32);
      }
#pragma unroll
      for (int r = 1; r >= 0; --r) {
        const int o = r * 8;
        float run = carry * (h == 0 ? Tp[r] : 1.f);
#pragma unroll
        for (int jj = 7; jj >= 0; --jj) {
          const float wv = sg[o + jj] * run;
          run *= fz[o + jj];
          sg[o + jj] = wv;
        }
        carry *= T[r] * Tp[r];
      }
      pv_half(Ks + 64 * KROW, sg, oacc, st, hd, lane);
    }
    if (idx + 1 < ntiles) store_tile(kt - 1, smem + ((idx + 1) & 1) * KV_BUF);
    int* flags = (int*)(smem + BIAS_OFF) + (idx & 1) * 4;
    const unsigned long long bal = __ballot(carry != 0.f);
    if (lane == 0) flags[w] = (bal != 0ull) ? 1 : 0;
    __syncthreads();
    const int alive = flags[0] | flags[1] | flags[2] | flags[3];
    if (!alive) break;
  }
  __syncthreads();
  attn_store(p, oacc, 1.f, tok, head, h);
}

DI void final_rows(const Params& p, int item) {
  const int t_ = tid(), lane = t_ & 63, w = t_ >> 6, row = item * 4 + w;
  const f32x4* s4 = (const f32x4*)(p.ss2 + (size_t)row * 16);
  f32x4 a = s4[0], b = s4[1], c = s4[2], d = s4[3];
  const float s = ((a.x + a.y) + (a.z + a.w)) + ((b.x + b.y) + (b.z + b.w)) + ((c.x + c.y) + (c.z + c.w)) + ((d.x + d.y) + (d.z + d.w));
  const float rstd = __builtin_amdgcn_rsqf(s * (1.f / 1024.f) + EPS);
  float* y = p.out + (size_t)row * 1024;
#pragma unroll
  for (int i = 0; i < 4; ++i) {
    const int cidx = (i * 64 + lane) * 4;
    f32x4 v = *(const f32x4*)(y + cidx);
    f32x4 g = *(const f32x4*)(p.norm_f + cidx);
    f32x4 o = {v.x * rstd * g.x, v.y * rstd * g.y, v.z * rstd * g.z, v.w * rstd * g.w};
    *(f32x4*)(y + cidx) = o;
  }
}

__global__ void __launch_bounds__(256, 2) yoco_mega(Params p, int ph_lo, int ph_hi) {
  extern __shared__ __attribute__((aligned(16))) char smem[];
  const int bid = blockIdx.x, nb = gridDim.x;
  for (int ph = ph_lo; ph < ph_hi; ++ph) {
    switch (ph) {
      case 0:
        for (int i = bid; i < 2560; i += nb) prep_wtile(p, i, smem);
        for (int i = bid; i < MT / 4; i += nb) prep_xrows(p, i);
        break;
      case 1: for (int i = bid; i < 272 * 32; i += nb) gemm_tile<1>(p, i, smem); break;
      case 2: for (int i = bid; i < 4352; i += nb) band_item(p, i, smem); break;
      case 3: for (int i = bid; i < 272 * 8; i += nb) gemm_tile<2>(p, i, smem); break;
      case 4: for (int i = bid; i < 272 * 32; i += nb) gemm_tile<3>(p, i, smem); break;
      case 5: for (int i = bid; i < 4352; i += nb) sb_item(p, i, smem); break;
      case 6: for (int i = bid; i < 272 * 8; i += nb) gemm_tile<4>(p, i, smem); break;
      default: for (int i = bid; i < MT / 4; i += nb) final_rows(p, i); break;
    }
    if (ph + 1 < ph_hi) cg::this_grid().sync();
  }
}

extern "C" void kernel_launch(void* const* d_in, const int* in_sizes, int n_in, void* d_out, int out_size,
                              void* d_ws, size_t ws_size, hipStream_t stream) {
  static int grid_blocks = 0;
  if (!grid_blocks) {
    int dev = 0, cus = 0, per_cu = 0;
    hipGetDevice(&dev);
    hipDeviceGetAttribute(&cus, hipDeviceAttributeMultiprocessorCount, dev);
    hipFuncSetAttribute((const void*)yoco_mega, hipFuncAttributeMaxDynamicSharedMemorySize, SMEM_BYTES);
    hipOccupancyMaxActiveBlocksPerMultiprocessor(&per_cu, yoco_mega, 256, SMEM_BYTES);
    if (per_cu < 1) per_cu = 1;
    grid_blocks = cus * per_cu;
  }
  Params p{};
  p.x_prompt = (const float*)d_in[0]; p.x_sample = (const float*)d_in[1];
  p.cache_a_k = (const float*)d_in[2]; p.cache_a_v = (const float*)d_in[3];
  p.cache_b_k = (const float*)d_in[4]; p.cache_b_v = (const float*)d_in[5];
  p.norm_a = (const float*)d_in[6]; p.w_in_a = (const float*)d_in[7]; p.rel_bias_a = (const float*)d_in[8];
  p.w_out_a = (const float*)d_in[9]; p.norm_kv = (const float*)d_in[10]; p.w_kv = (const float*)d_in[11];
  p.norm_b = (const float*)d_in[12]; p.w_in_b = (const float*)d_in[13]; p.w_out_b = (const float*)d_in[14];
  p.norm_f = (const float*)d_in[15];
  p.out = (float*)d_out;
  char* ws = (char*)d_ws;
  p.Wa = (bf16*)(ws + WS_WA); p.Woa = (bf16*)(ws + WS_WOA); p.Wb = (bf16*)(ws + WS_WB); p.Wob = (bf16*)(ws + WS_WOB);
  p.xb = (bf16*)(ws + WS_XB); p.qkvg = (bf16*)(ws + WS_QKVG); p.ao = (bf16*)(ws + WS_AO);
  p.x1 = (float*)(ws + WS_X1); p.ss0 = (float*)(ws + WS_SS0); p.ss1 = (float*)(ws + WS_SS1); p.ss2 = (float*)(ws + WS_SS2);
#if ONE_LAUNCH
  int lo = 0, hi = 8;
  void* args[] = {&p, &lo, &hi};
  hipError_t e = hipLaunchCooperativeKernel((const void*)yoco_mega, dim3(grid_blocks), dim3(256), args, SMEM_BYTES, stream);
  if (e != hipSuccess) fprintf(stderr, "cooperative launch failed: %s (grid %d)\n", hipGetErrorString(e), grid_blocks);
#else
  for (int ph = 0; ph < 8; ++ph)
    hipLaunchKernelGGL(yoco_mega, dim3(grid_blocks), dim3(256), SMEM_BYTES, stream, p, ph, ph + 1);
#endif
}
```

```cpp
#include <hip/hip_runtime.h>
#include <hip/hip_cooperative_groups.h>
#include <cstdio>
namespace cg = cooperative_groups;

#ifndef DUP_MASK
#define DUP_MASK 0
#endif
#ifndef ONE_LAUNCH
#define ONE_LAUNCH 1
#endif

typedef __bf16 bf16;
typedef __bf16 bf16x2 __attribute__((ext_vector_type(2)));
typedef __bf16 bf16x4 __attribute__((ext_vector_type(4)));
typedef __bf16 bf16x8 __attribute__((ext_vector_type(8)));
typedef float f32x2 __attribute__((ext_vector_type(2)));
typedef float f32x4 __attribute__((ext_vector_type(4)));
typedef float f32x16 __attribute__((ext_vector_type(16)));
typedef unsigned u32x2 __attribute__((ext_vector_type(2)));
typedef unsigned u32x4 __attribute__((ext_vector_type(4)));
typedef __attribute__((address_space(3))) bf16x4 lds_bf16x4;

#define DI __device__ __forceinline__
#define MFMA(a, b, c) __builtin_amdgcn_mfma_f32_32x32x16_bf16((a), (b), (c), 0, 0, 0)
#define MFMA16(a, b, c) __builtin_amdgcn_mfma_f32_16x16x32_bf16((a), (b), (c), 0, 0, 0)

constexpr int TP = 32768;
constexpr int MT = 34816;
constexpr float LOG2E = 1.4426950408889634f;
constexpr float QSCALE = 0.125f * LOG2E;
constexpr float EPS = 1e-6f;

constexpr size_t OFF_AKP = 35651584, OFF_AVP = 44040192, OFF_KBP = 52428800, OFF_VBP = 85983232;
constexpr size_t OFF_AKS = 119537664, OFF_AVS = 121634816, OFF_KBS = 123731968, OFF_VBS = 125829120;
constexpr size_t WS_WA = 0, WS_WOA = 8388608, WS_WB = 10485760, WS_WOB = 18874368, WS_XB = 20971520;
constexpr size_t WS_QKVG = 92274688, WS_AO = 377487360, WS_X1 = 448790528, WS_SS0 = 591396864;
constexpr size_t WS_SS1 = 591536128, WS_SS2 = 593764352, WS_BAR = 595992576;

constexpr int NTHR = 512;
constexpr int SMEM_BYTES = 147968;
constexpr int KROW = 528, VROW = 576;
constexpr int KV_BUF = 64 * KROW + 64 * VROW;
constexpr int BIAS_OFF = 2 * KV_BUF;
constexpr int XBST_OFF = 147952;
constexpr int RSTD_OFF = 136192;
constexpr int STG_ROW = 272, STG_WAVE = 32 * STG_ROW;

struct Params {
  const float *x_prompt, *x_sample, *cache_a_k, *cache_a_v, *cache_b_k, *cache_b_v;
  const float *norm_a, *w_in_a, *rel_bias_a, *w_out_a, *norm_kv, *w_kv, *norm_b, *w_in_b, *w_out_b, *norm_f;
  float* out;
  bf16 *Wa, *Woa, *Wb, *Wob, *xb, *qkvg, *ao;
  float *x1, *ss0, *ss1, *ss2;
  unsigned* bar;
};

DI unsigned pk(float a, float b) { f32x2 v = {a, b}; return __builtin_bit_cast(unsigned, __builtin_convertvector(v, bf16x2)); }
DI float bf_lo(unsigned u) { return __uint_as_float(u << 16); }
DI float bf_hi(unsigned u) { return __uint_as_float(u & 0xffff0000u); }
DI float silu(float x) { return x * __builtin_amdgcn_rcpf(1.f + __builtin_amdgcn_exp2f(-x * LOG2E)); }
DI int tid() { int t = threadIdx.x; asm volatile("" : "+v"(t)); return t; }
DI int pi_swap(int m) { return (m & ~12) | ((m & 4) << 1) | ((m & 8) >> 1); }

DI void prep_wtile(const Params& p, int item, char* smem) {
  float* lds = (float*)smem;
  const float* W; const float* g; bf16* Wt; int N, local;
  if (item < 1024)      { W = p.w_in_a;  N = 4096; g = p.norm_a;  Wt = p.Wa;  local = item; }
  else if (item < 1280) { W = p.w_out_a; N = 1024; g = nullptr;   Wt = p.Woa; local = item - 1024; }
  else if (item < 1792) { W = p.w_kv;    N = 2048; g = p.norm_kv; Wt = p.Wb;  local = item - 1280; }
  else if (item < 2304) { W = p.w_in_b;  N = 2048; g = p.norm_b;  Wt = p.Wb + (size_t)2048 * 1024; local = item - 1792; }
  else                  { W = p.w_out_b; N = 1024; g = nullptr;   Wt = p.Wob; local = item - 2304; }
  const int ntn = N >> 6, kt = local / ntn, nt = local % ntn, t = tid();
#pragma unroll
  for (int pass = 0; pass < 2; ++pass) {
    const int r = (t >> 4) + 32 * pass, c4 = (t & 15) * 4;
    f32x4 v = __builtin_nontemporal_load((const f32x4*)(W + (size_t)(kt * 64 + r) * N + nt * 64 + c4));
    const float gg = g ? g[kt * 64 + r] : 1.f;
    lds[r * 65 + c4 + 0] = v.x * gg; lds[r * 65 + c4 + 1] = v.y * gg;
    lds[r * 65 + c4 + 2] = v.z * gg; lds[r * 65 + c4 + 3] = v.w * gg;
  }
  __syncthreads();
  {
    const int n = t >> 3, kg = t & 7;
    u32x4 o;
    o.x = pk(lds[(8 * kg + 0) * 65 + n], lds[(8 * kg + 1) * 65 + n]);
    o.y = pk(lds[(8 * kg + 2) * 65 + n], lds[(8 * kg + 3) * 65 + n]);
    o.z = pk(lds[(8 * kg + 4) * 65 + n], lds[(8 * kg + 5) * 65 + n]);
    o.w = pk(lds[(8 * kg + 6) * 65 + n], lds[(8 * kg + 7) * 65 + n]);
    *(u32x4*)(Wt + (size_t)(nt * 64 + n) * 1024 + kt * 64 + 8 * kg) = o;
  }
  __syncthreads();
}

DI const float* xrow(const Params& p, int row) {
  return row < TP ? p.x_prompt + (size_t)row * 1024 : p.x_sample + (size_t)(row - TP) * 1024;
}

DI void prep_xrows(const Params& p, int item) {
  const int t_ = tid(), lane = t_ & 63, w = t_ >> 6, row0 = item * 32 + w * 4;
  f32x4 v[4][4];
#pragma unroll
  for (int r = 0; r < 4; ++r) {
    const float* x = xrow(p, row0 + r);
#pragma unroll
    for (int i = 0; i < 4; ++i) v[r][i] = __builtin_nontemporal_load((const f32x4*)(x + (i * 64 + lane) * 4));
  }
#pragma unroll
  for (int r = 0; r < 4; ++r) {
    float ss = 0.f;
#pragma unroll
    for (int i = 0; i < 4; ++i) {
      ss += v[r][i].x * v[r][i].x + v[r][i].y * v[r][i].y + v[r][i].z * v[r][i].z + v[r][i].w * v[r][i].w;
      u32x2 o = {pk(v[r][i].x, v[r][i].y), pk(v[r][i].z, v[r][i].w)};
      *(u32x2*)(p.xb + (size_t)(row0 + r) * 1024 + (i * 64 + lane) * 4) = o;
    }
#pragma unroll
    for (int m = 32; m >= 1; m >>= 1) ss += __shfl_xor(ss, m);
    if (lane == 0) p.ss0[row0 + r] = ss;
  }
}

DI void glds16(const void* gsrc, unsigned lds_dst) {
  unsigned keep;
  asm volatile("s_mov_b32 %0, m0\n\ts_mov_b32 m0, %2\n\ts_nop 0\n\tglobal_load_lds_dwordx4 %1, off\n\ts_mov_b32 m0, %0"
               : "=&s"(keep) : "v"(gsrc), "s"(lds_dst) : "memory");
}
template <int MODE, int TJ>
DI void gemm_tile(const Params& p, int tm, int tn, bool have0, int ntm, int ntn, char* smem) {
  const bf16* A = (MODE == 1 || MODE == 3) ? p.xb : p.ao;
  const bf16* W = MODE == 1 ? p.Wa : MODE == 2 ? p.Woa : MODE == 3 ? p.Wb : p.Wob;
  const int t = tid(), lane = t & 63, w = t >> 6, wn = w & 3, wm = w >> 2, l32 = lane & 31, h = lane >> 5;
  constexpr int XI = TJ;
  const int lc = (t & 7) ^ ((t >> 4) & 7);
  const bf16* Ag = A + (size_t)(tm * (TJ * 64) + (t >> 3)) * 1024 + lc * 8;
  const bf16* Wg = W + (size_t)(tn * 256 + (t >> 3)) * 1024 + lc * 8;
  const unsigned lds_w = __builtin_amdgcn_readfirstlane((unsigned)(size_t)smem + (unsigned)w * 1024u);
  const int crow = lane >> 4, cch = lane & 15;
  const int col0 = tn * 256 + wn * 64;
  const int l16 = lane & 15, q4 = lane >> 4;
  f32x4 acc[4][2 * TJ];
#pragma unroll
  for (int a = 0; a < 4; ++a)
#pragma unroll
    for (int b = 0; b < 2 * TJ; ++b)
#pragma unroll
      for (int i = 0; i < 4; ++i) acc[a][b][i] = 0.f;

  auto issue = [&](const bf16* ag, const bf16* wg, int kt, int buf) {
    const unsigned sb = lds_w + (unsigned)buf * 65536u;
#pragma unroll
    for (int i = 0; i < XI; ++i) glds16(ag + (size_t)(64 * i) * 1024 + kt * 64, sb + i * 8192u);
#pragma unroll
    for (int i = 0; i < 4; ++i) glds16(wg + (size_t)(64 * i) * 1024 + kt * 64, sb + 32768u + i * 8192u);
  };
  if (!have0) issue(Ag, Wg, 0, 0);
  const int swz = (l16 >> 1) & 7;
  int xa[2], wa[2];
#pragma unroll
  for (int s2 = 0; s2 < 2; ++s2) {
    const int off = (((4 * s2 + q4) ^ swz) * 16);
    xa[s2] = (wm * (TJ * 32) + l16) * 128 + off;
    wa[s2] = 32768 + (wn * 64 + l16) * 128 + off;
  }
  f32x4 sp0, sp1, sp2, sp3; float sp = 0.f;
  if (MODE == 1) { if (t < TJ * 64) sp = p.ss0[tm * (TJ * 64) + t]; }
  if (MODE == 3) {
    if (t < TJ * 64) {
      const f32x4* s4 = (const f32x4*)(p.ss1 + (size_t)(tm * (TJ * 64) + t) * 16);
      sp0 = s4[0]; sp1 = s4[1]; sp2 = s4[2]; sp3 = s4[3];
    }
  }
  asm volatile("s_waitcnt vmcnt(0)" ::: "memory");
  __syncthreads();
  issue(Ag, Wg, 1, 1);
  if (MODE == 1 || MODE == 3) {
    if (t < TJ * 64) {
      if (MODE == 3) sp = ((sp0.x + sp0.y) + (sp0.z + sp0.w)) + ((sp1.x + sp1.y) + (sp1.z + sp1.w)) + ((sp2.x + sp2.y) + (sp2.z + sp2.w)) + ((sp3.x + sp3.y) + (sp3.z + sp3.w));
      ((float*)(smem + RSTD_OFF))[t] = __builtin_amdgcn_rsqf(sp * (1.f / 1024.f) + EPS);
    }
  }
  f32x4 rres[(MODE == 2 || MODE == 4) ? TJ : 1][8];
  bf16x8 wfr[4], ax[TJ], bx[TJ];
  auto ldx = [&](int s2, int uh, const char* base, bf16x8* fx) {
#pragma unroll
    for (int uu = 0; uu < TJ; ++uu) fx[uu] = *(const bf16x8*)(base + xa[s2] + (uh * TJ + uu) * 2048);
  };
  auto mma_all = [&](int uh, const bf16x8* fx) {
    __builtin_amdgcn_sched_barrier(0);
#pragma unroll
    for (int f = 0; f < 4; ++f)
#pragma unroll
      for (int uu = 0; uu < TJ; ++uu) acc[f][uh * TJ + uu] = MFMA16(wfr[f], fx[uu], acc[f][uh * TJ + uu]);
    __builtin_amdgcn_sched_barrier(0);
  };
  auto mma_refresh = [&](int uh, const bf16x8* fx, const char* wbase, int s2, bool reload) {
#pragma unroll
    for (int f = 0; f < 4; ++f) {
      __builtin_amdgcn_sched_barrier(0);
#pragma unroll
      for (int uu = 0; uu < TJ; ++uu) acc[f][uh * TJ + uu] = MFMA16(wfr[f], fx[uu], acc[f][uh * TJ + uu]);
      __builtin_amdgcn_sched_barrier(0);
      if (reload) wfr[f] = *(const bf16x8*)(wbase + wa[s2] + f * 2048);
    }
  };
#pragma unroll
  for (int f = 0; f < 4; ++f) wfr[f] = *(const bf16x8*)(smem + wa[0] + f * 2048);
  ldx(0, 0, smem, ax);
  for (int kt = 0; kt < 16; ++kt) {
    const char* base = smem + (kt & 1) * 65536;
    const char* nbase = smem + ((kt + 1) & 1) * 65536;
    ldx(0, 1, base, bx); mma_all(0, ax);
    ldx(1, 0, base, ax); mma_refresh(1, bx, base, 1, true);
    ldx(1, 1, base, bx); mma_all(0, ax);
    if (kt < 15) {
      asm volatile("s_waitcnt vmcnt(0) lgkmcnt(0)" ::: "memory");
      __syncthreads();
      if (kt < 14) issue(Ag, Wg, kt + 2, kt & 1);
      if ((MODE == 2 || MODE == 4) && kt == 0) {
#pragma unroll
        for (int tj = 0; tj < TJ; ++tj) {
          const int tok0 = tm * (TJ * 64) + wm * (TJ * 32) + tj * 32;
          if (MODE == 2) {
            const float* res = xrow(p, tok0) + col0 + 4 * cch;
#pragma unroll
            for (int ps = 0; ps < 8; ++ps) rres[tj][ps] = __builtin_nontemporal_load((const f32x4*)(res + (size_t)(crow + 4 * ps) * 1024));
          } else {
            const bf16* res = p.xb + (size_t)tok0 * 1024 + col0 + 4 * cch;
#pragma unroll
            for (int ps = 0; ps < 8; ++ps) {
              const u32x2 r2 = __builtin_nontemporal_load((const u32x2*)(res + (size_t)(crow + 4 * ps) * 1024));
              rres[tj][ps] = f32x4{__uint_as_float(r2.x), __uint_as_float(r2.y), 0.f, 0.f};
            }
          }
        }
      }
      ldx(0, 0, nbase, ax);
    }
    mma_refresh(1, bx, nbase, 0, kt < 15);
  }
  if (ntm >= 0) {
    const bf16* nAg = A + (size_t)(ntm * (TJ * 64) + (t >> 3)) * 1024 + lc * 8;
    const bf16* nWg = W + (size_t)(ntn * 256 + (t >> 3)) * 1024 + lc * 8;
    issue(nAg, nWg, 0, 0);
  }
  asm volatile("s_waitcnt lgkmcnt(0)" ::: "memory");
  __syncthreads();

  {
  const int t = tid(), lane = t & 63, w = t >> 6, wn = w & 3, wm = w >> 2, l16 = lane & 15, q4 = lane >> 4, crow = lane >> 4, cch = lane & 15;
  const int col0 = tn * 256 + wn * 64;
  char* sw = smem + 65536 + w * STG_WAVE;
#pragma unroll
  for (int tj = 0; tj < TJ; ++tj) {
    const int tok0 = tm * (TJ * 64) + wm * (TJ * 32) + tj * 32;
    if (MODE == 1 || MODE == 3) {
      const int type = tn >> 2;
      constexpr int QT = (MODE == 1) ? 0 : 2;
#pragma unroll
      for (int u2 = 0; u2 < 2; ++u2) {
        const float rstd = ((const float*)(smem + RSTD_OFF))[wm * (TJ * 32) + tj * 32 + 16 * u2 + l16];
        const float mul = (type == QT) ? rstd * QSCALE : rstd;
#pragma unroll
        for (int f = 0; f < 4; ++f) {
          f32x4 v = acc[f][2 * tj + u2] * mul;
          if (type == 3) { v.x = silu(v.x); v.y = silu(v.y); v.z = silu(v.z); v.w = silu(v.w); }
          *(f32x4*)(sw + (16 * u2 + l16) * STG_ROW + (16 * f + 4 * q4) * 4) = v;
        }
      }
      asm volatile("s_waitcnt lgkmcnt(0)" ::: "memory");
      float* fout = nullptr;
      const int c = (col0 & 1023) + 4 * cch;
      if (MODE == 1) {
        if (type == 1 || type == 2) {
          if (tok0 < TP) { const int tt = tok0 & 2047; if (tt >= 1536) fout = p.out + (type == 1 ? OFF_AKP : OFF_AVP) + ((size_t)((tok0 >> 11) * 512 + tt - 1536)) * 1024 + c; }
          else fout = p.out + (type == 1 ? OFF_AKS : OFF_AVS) + (size_t)(tok0 - TP) * 1024 + c;
        }
      } else {
        if (type == 0 || type == 1) {
          if (tok0 < TP) fout = p.out + (type == 0 ? OFF_KBP : OFF_VBP) + (size_t)tok0 * 1024 + c;
          else fout = p.out + (type == 0 ? OFF_KBS : OFF_VBS) + (size_t)(tok0 - TP) * 1024 + c;
        }
      }
      bf16* bout = p.qkvg + (size_t)tok0 * 4096 + col0 + 4 * cch;
      f32x4 vb[8];
#pragma unroll
      for (int ps = 0; ps < 8; ++ps) vb[ps] = *(const f32x4*)(sw + (crow + 4 * ps) * STG_ROW + cch * 16);
      asm volatile("s_waitcnt lgkmcnt(0)" ::: "memory");
#pragma unroll
      for (int ps = 0; ps < 8; ++ps) {
        const int row = crow + 4 * ps;
        u32x2 o = {pk(vb[ps].x, vb[ps].y), pk(vb[ps].z, vb[ps].w)};
        *(u32x2*)(bout + (size_t)row * 4096) = o;
      }
      if (fout) {
#pragma unroll
        for (int ps = 0; ps < 8; ++ps) __builtin_nontemporal_store(vb[ps], (f32x4*)(fout + (size_t)(crow + 4 * ps) * 1024));
      }
    } else {
#pragma unroll
      for (int ps = 0; ps < 8; ++ps) {
        f32x4 r = rres[tj][ps];
        if (MODE == 4) { const unsigned a = __float_as_uint(r.x), b2 = __float_as_uint(r.y); r = f32x4{bf_lo(a), bf_hi(a), bf_lo(b2), bf_hi(b2)}; }
        *(f32x4*)(sw + (crow + 4 * ps) * STG_ROW + cch * 16) = r;
      }
      asm volatile("s_waitcnt lgkmcnt(0)" ::: "memory");
      float ssq[2] = {0.f, 0.f};
#pragma unroll
      for (int u2 = 0; u2 < 2; ++u2)
#pragma unroll
        for (int f = 0; f < 4; ++f) {
          f32x4* q = (f32x4*)(sw + (16 * u2 + l16) * STG_ROW + (16 * f + 4 * q4) * 4);
          const f32x4 y = *q + acc[f][2 * tj + u2];
          ssq[u2] += y.x * y.x + y.y * y.y + y.z * y.z + y.w * y.w;
          *q = y;
        }
      asm volatile("s_waitcnt lgkmcnt(0)" ::: "memory");
      float* ssd = (MODE == 2) ? p.ss1 : p.ss2;
#pragma unroll
      for (int u2 = 0; u2 < 2; ++u2) {
        float sv = ssq[u2];
        sv += __shfl_xor(sv, 16);
        sv += __shfl_xor(sv, 32);
        if (q4 == 0) ssd[(size_t)(tok0 + 16 * u2 + l16) * 16 + tn * 4 + wn] = sv;
      }
      bf16* bo = ((MODE == 2) ? p.xb : (bf16*)p.x1) + (size_t)tok0 * 1024 + col0 + 4 * cch;
      f32x4 yb[8];
#pragma unroll
      for (int ps = 0; ps < 8; ++ps) yb[ps] = *(const f32x4*)(sw + (crow + 4 * ps) * STG_ROW + cch * 16);
      asm volatile("s_waitcnt lgkmcnt(0)" ::: "memory");
#pragma unroll
      for (int ps = 0; ps < 8; ++ps) { u32x2 o = {pk(yb[ps].x, yb[ps].y), pk(yb[ps].z, yb[ps].w)}; *(u32x2*)(bo + (size_t)(crow + 4 * ps) * 1024) = o; }
    }
    asm volatile("s_waitcnt lgkmcnt(0)" ::: "memory");
  }
  }
}

DI void kv_load_bf16(const bf16* kb, const bf16* vb, u32x4* stg, int t) {
#pragma unroll
  for (int i = 0; i < 4; ++i) stg[i] = *(const u32x4*)(kb + (size_t)((t >> 5) + 16 * i) * 4096 + (t & 31) * 8);
#pragma unroll
  for (int i = 0; i < 4; ++i) stg[4 + i] = *(const u32x4*)(vb + (size_t)((t >> 5) + 16 * i) * 4096 + (t & 31) * 8);
}
DI void kv_store_bf16(char* Ks, const u32x4* stg, int t) {
  char* Vs = Ks + 64 * KROW;
#pragma unroll
  for (int i = 0; i < 4; ++i) *(u32x4*)(Ks + ((t >> 5) + 16 * i) * KROW + (t & 31) * 16) = stg[i];
#pragma unroll
  for (int i = 0; i < 4; ++i) *(u32x4*)(Vs + ((t >> 5) + 16 * i) * VROW + (t & 31) * 16) = stg[4 + i];
}
DI void kv_load_f32(const float* kf, const float* vf, u32x4* stg, int t) {
#pragma unroll
  for (int i = 0; i < 4; ++i) {
    const float* a = kf + (size_t)((t >> 5) + 16 * i) * 1024 + (t & 31) * 8;
    f32x4 v0 = __builtin_nontemporal_load((const f32x4*)a), v1 = __builtin_nontemporal_load((const f32x4*)(a + 4));
    u32x4 o = {pk(v0.x, v0.y), pk(v0.z, v0.w), pk(v1.x, v1.y), pk(v1.z, v1.w)};
    stg[i] = o;
  }
#pragma unroll
  for (int i = 0; i < 4; ++i) {
    const float* a = vf + (size_t)((t >> 5) + 16 * i) * 1024 + (t & 31) * 8;
    f32x4 v0 = __builtin_nontemporal_load((const f32x4*)a), v1 = __builtin_nontemporal_load((const f32x4*)(a + 4));
    u32x4 o = {pk(v0.x, v0.y), pk(v0.z, v0.w), pk(v1.x, v1.y), pk(v1.z, v1.w)};
    stg[4 + i] = o;
  }
}

DI void qk_half(const char* Ks, const bf16x8* qf, f32x16& sacc, int st, int hd, int l32, int h) {
  const int prow = pi_swap(l32);
#pragma unroll
  for (int i = 0; i < 16; ++i) sacc[i] = 0.f;
#pragma unroll
  for (int s = 0; s < 4; ++s) {
    bf16x8 kf = *(const bf16x8*)(Ks + (32 * st + prow) * KROW + (hd * 64 + 16 * s + 8 * h) * 2);
    sacc = MFMA(kf, qf[s], sacc);
  }
}
DI void pv_half(const char* Vs, const f32x16& pw, f32x16* oacc, int st, int hd, int lane) {
  const int h = lane >> 5, qd = (lane & 15) >> 2, blk = (lane >> 4) & 1, pp = lane & 3;
  const char* vbase = Vs + (32 * st + 8 * h + qd) * VROW + hd * 128 + blk * 32 + pp * 8;
#pragma unroll
  for (int ss = 0; ss < 2; ++ss) {
    u32x4 pu = {pk(pw[8 * ss + 0], pw[8 * ss + 1]), pk(pw[8 * ss + 2], pw[8 * ss + 3]),
                pk(pw[8 * ss + 4], pw[8 * ss + 5]), pk(pw[8 * ss + 6], pw[8 * ss + 7])};
    bf16x8 pf = __builtin_bit_cast(bf16x8, pu);
#pragma unroll
    for (int dt = 0; dt < 2; ++dt) {
      const char* a = vbase + (16 * ss) * VROW + dt * 64;
      bf16x4 lo = __builtin_amdgcn_ds_read_tr16_b64_v4bf16((lds_bf16x4*)(a));
      bf16x4 hi = __builtin_amdgcn_ds_read_tr16_b64_v4bf16((lds_bf16x4*)(a + 4 * VROW));
      bf16x8 vf = __builtin_shufflevector(lo, hi, 0, 1, 2, 3, 4, 5, 6, 7);
      oacc[dt] = MFMA(vf, pf, oacc[dt]);
    }
  }
}
DI void attn_stage(const f32x16* oacc, float scale, int lane, char* sw) {
  const int l32 = lane & 31, h = lane >> 5;
#pragma unroll
  for (int dt = 0; dt < 2; ++dt)
#pragma unroll
    for (int g = 0; g < 4; ++g) {
      f32x4 v = {oacc[dt][4 * g + 0] * scale, oacc[dt][4 * g + 1] * scale, oacc[dt][4 * g + 2] * scale, oacc[dt][4 * g + 3] * scale};
      *(f32x4*)(sw + l32 * STG_ROW + (dt * 32 + 8 * g + 4 * h) * 4) = v;
    }
  asm volatile("s_waitcnt lgkmcnt(0)" ::: "memory");
}
DI void gate_load(const Params& p, u32x2* greg, int tok0, int head, int lane) {
  const bf16* gsrc = p.qkvg + (size_t)tok0 * 4096 + 3072 + head * 64 + 4 * (lane & 15);
#pragma unroll
  for (int ps = 0; ps < 8; ++ps) greg[ps] = __builtin_nontemporal_load((const u32x2*)(gsrc + (size_t)((lane >> 4) + 4 * ps) * 4096));
}
DI void attn_flush(const Params& p, const u32x2* greg, int tok0, int head, int lane, const char* sw) {
  const int crow = lane >> 4, cch = lane & 15;
  bf16* dst = p.ao + (size_t)tok0 * 1024 + head * 64 + 4 * cch;
#pragma unroll
  for (int ps = 0; ps < 8; ++ps) {
    const int row = crow + 4 * ps;
    f32x4 v = *(const f32x4*)(sw + row * STG_ROW + cch * 16);
    u32x2 sg = greg[ps];
    u32x2 o = {pk(v.x * bf_lo(sg.x), v.y * bf_hi(sg.x)), pk(v.z * bf_lo(sg.y), v.w * bf_hi(sg.y))};
    *(u32x2*)(dst + (size_t)row * 1024) = o;
  }
}

DI void band_phase(const Params& p, char* smem, int bid, int nb) {
  const int t = tid(), lane = t & 63, w = t >> 6, hd = w >> 1, qsub = w & 1, l32 = lane & 31, h = lane >> 5;
  const int hp = bid & 3, head = hp * 4 + hd;
  float* bias = (float*)(smem + BIAS_OFF);
  for (int i = t; i < 4 * 320; i += NTHR) {
    const int hh = i / 320, r = i % 320;
    bias[hh * 320 + r] = p.rel_bias_a[(hp * 4 + hh) * 257 + (r > 256 ? 256 : r)] * LOG2E;
  }
  const float* bh = bias + hd * 320;
  char* sw = smem + w * STG_WAVE;
  int item = bid;
  if (item >= 2176) return;
  int b, c, qrow0, ntiles; bool sample;
  auto decode = [&](int it) {
    sample = it >= 2048;
    if (!sample) { const int x = it & 7; c = (((it >> 3) & 31) + 4 * (it >> 8)) & 31; b = (it >> 8) * 2 + (x >> 2); qrow0 = b * 2048 + c * 64; ntiles = (c < 8 ? c : 8) + 1; }
    else { b = it - 2048; c = 8; qrow0 = TP + b * 64; ntiles = 9; }
  };
  bf16x8 qf[4];
  u32x4 stg[8];
  auto load_q = [&]() {
    const bf16* q = p.qkvg + (size_t)(qrow0 + qsub * 32 + l32) * 4096 + head * 64 + 8 * h;
#pragma unroll
    for (int s2 = 0; s2 < 4; ++s2) qf[s2] = *(const bf16x8*)(q + 16 * s2);
  };
  auto load_tile = [&](int j) {
    if (!sample) {
      const bf16* kb = p.qkvg + (size_t)(b * 2048 + j * 64) * 4096 + 1024 + hp * 256;
      kv_load_bf16(kb, kb + 1024, stg, t);
    } else if (j < 8) {
      const size_t o = (size_t)(b * 512 + j * 64) * 1024 + hp * 256;
      kv_load_f32(p.cache_a_k + o, p.cache_a_v + o, stg, t);
    } else {
      const bf16* kb = p.qkvg + (size_t)(TP + b * 64) * 4096 + 1024 + hp * 256;
      kv_load_bf16(kb, kb + 1024, stg, t);
    }
  };
  decode(item);
  load_q(); load_tile(c + 1 - ntiles);
  for (;;) {
    const int j0 = c + 1 - ntiles, tok0 = qrow0 + qsub * 32;
    kv_store_bf16(smem, stg, t);
    __syncthreads();
    f32x16 oacc[2];
#pragma unroll
    for (int d = 0; d < 2; ++d)
#pragma unroll
      for (int i = 0; i < 16; ++i) oacc[d][i] = 0.f;
    float m_run = -1e30f, l_run = 0.f;
    u32x2 greg[8];
    for (int idx = 0; idx < ntiles; ++idx) {
      const int j = j0 + idx;
      if (idx + 1 < ntiles) load_tile(j + 1);
      __builtin_amdgcn_sched_barrier(0);
      const char* Ks = smem + (idx & 1) * KV_BUF;
      const int dj = c - j;
      const float cb = bh[256];
      const int idx0 = dj * 64 + qsub * 32 + l32 - 8 * h;
      f32x16 sacc[2];
      qk_half(Ks, qf, sacc[0], 0, hd, l32, h);
      qk_half(Ks, qf, sacc[1], 1, hd, l32, h);
      if (dj >= 3) {
#pragma unroll
        for (int st = 0; st < 2; ++st)
#pragma unroll
          for (int i = 0; i < 16; ++i) sacc[st][i] += cb;
      } else {
#pragma unroll
        for (int st = 0; st < 2; ++st)
#pragma unroll
          for (int i = 0; i < 16; ++i) sacc[st][i] += bh[idx0 + 128 - (32 * st + 16 * (i >> 3) + (i & 7))];
      }
      float mx0 = sacc[0][0], mx1 = sacc[1][0];
#pragma unroll
      for (int i = 1; i < 16; ++i) { mx0 = fmaxf(mx0, sacc[0][i]); mx1 = fmaxf(mx1, sacc[1][i]); }
      float mx = fmaxf(mx0, mx1);
      mx = fmaxf(mx, __shfl_xor(mx, 32));
      const float m_new = fmaxf(m_run, mx);
      const float alpha = __builtin_amdgcn_exp2f(m_run - m_new);
      m_run = m_new;
      float ls0 = 0.f, ls1 = 0.f;
#pragma unroll
      for (int i = 0; i < 16; ++i) {
        const float e0 = __builtin_amdgcn_exp2f(sacc[0][i] - m_new); sacc[0][i] = e0; ls0 += e0;
        const float e1 = __builtin_amdgcn_exp2f(sacc[1][i] - m_new); sacc[1][i] = e1; ls1 += e1;
      }
      l_run = l_run * alpha + (ls0 + ls1);
      if (__ballot(alpha != 1.f) != 0ull) {
#pragma unroll
        for (int d = 0; d < 2; ++d)
#pragma unroll
          for (int i = 0; i < 16; ++i) oacc[d][i] *= alpha;
      }
      pv_half(Ks + 64 * KROW, sacc[0], oacc, 0, hd, lane);
      pv_half(Ks + 64 * KROW, sacc[1], oacc, 1, hd, lane);
      if (idx + 1 < ntiles) kv_store_bf16(smem + ((idx + 1) & 1) * KV_BUF, stg, t);
      __syncthreads();
    }
    gate_load(p, greg, tok0, head, lane);
    const float l = l_run + __shfl_xor(l_run, 32);
    attn_stage(oacc, 1.f / l, lane, sw);
    int nxt = item + nb;
    if (nxt >= 2048) { const int g = bid >> 3; nxt = (item < 2048 && (g & 2) == 0) ? 2048 + (((g >> 2) * 2 + (g & 1)) * 2 + ((bid & 7) >> 2)) : 1 << 20; }
    const bool more = nxt < 2176;
    if (more) { decode(nxt); load_q(); load_tile(c + 1 - ntiles); }
    attn_flush(p, greg, tok0, head, lane, sw);
    __syncthreads();
    if (!more) break;
    item = nxt;
  }
}

DI void sb_phase(const Params& p, char* smem, int bid, int nb) {
  const int t = tid(), lane = t & 63, w = t >> 6, hd = w >> 1, qsub = w & 1, l32 = lane & 31, h = lane >> 5;
  const int hp = bid & 3, head = hp * 4 + hd;
  char* sw = smem + w * STG_WAVE;
  int item = bid;
  if (item >= 2176) return;
  int b, qt, qrow0, ntiles; bool sample;
  auto decode = [&](int it) {
    sample = it >= 2048;
    if (!sample) { const int x = it & 7; qt = 31 - ((((it >> 3) & 31) + 4 * (it >> 8)) & 31); b = (it >> 8) * 2 + (x >> 2); qrow0 = b * 2048 + qt * 64; ntiles = qt + 1; }
    else { b = it - 2048; qt = 32; qrow0 = TP + b * 64; ntiles = 33; }
  };
  bf16x8 qf[4];
  u32x4 stg[8];
  auto load_q = [&]() {
    const bf16* q = p.qkvg + (size_t)(qrow0 + qsub * 32 + l32) * 4096 + 2048 + head * 64 + 8 * h;
#pragma unroll
    for (int s2 = 0; s2 < 4; ++s2) qf[s2] = *(const bf16x8*)(q + 16 * s2);
  };
  auto load_tile = [&](int kt) {
    if (!sample) {
      const bf16* kb = p.qkvg + (size_t)(b * 2048 + kt * 64) * 4096 + hp * 256;
      kv_load_bf16(kb, kb + 1024, stg, t);
    } else if (kt == 32) {
      const bf16* kb = p.qkvg + (size_t)(TP + b * 64) * 4096 + hp * 256;
      kv_load_bf16(kb, kb + 1024, stg, t);
    } else {
      const size_t o = (size_t)(b * 2048 + kt * 64) * 1024 + hp * 256;
      kv_load_f32(p.cache_b_k + o, p.cache_b_v + o, stg, t);
    }
  };
  decode(item);
  load_q(); load_tile(qt);
  for (;;) {
    const int tok0 = qrow0 + qsub * 32;
    kv_store_bf16(smem, stg, t);
    __syncthreads();
    f32x16 oacc[2];
#pragma unroll
    for (int d = 0; d < 2; ++d)
#pragma unroll
      for (int i = 0; i < 16; ++i) oacc[d][i] = 0.f;
    float carry = 1.f;
    const int qlim = qsub * 32 + l32 - 8 * h;
    u32x2 greg[8];
    for (int idx = 0; idx < ntiles; ++idx) {
      const int kt = qt - idx;
      if (idx + 1 < ntiles) load_tile(kt - 1);
      __builtin_amdgcn_sched_barrier(0);
      const char* Ks = smem + (idx & 1) * KV_BUF;
      const bool diag = (idx == 0);
      f32x16 fz[2], sg[2];
      qk_half(Ks, qf, fz[1], 1, hd, l32, h);
      qk_half(Ks, qf, fz[0], 0, hd, l32, h);
#pragma unroll
      for (int st = 0; st < 2; ++st)
#pragma unroll
        for (int i = 0; i < 16; ++i) {
          const float e = __builtin_amdgcn_exp2f(fminf(fz[st][i], 100.f));
          const float f = __builtin_amdgcn_rcpf(1.f + e);
          fz[st][i] = f; sg[st][i] = e * f;
        }
      if (diag) {
#pragma unroll
        for (int st = 0; st < 2; ++st)
#pragma unroll
          for (int i = 0; i < 16; ++i) {
            const bool valid = (32 * st + 16 * (i >> 3) + (i & 7)) < qlim;
            fz[st][i] = valid ? fz[st][i] : 1.f; sg[st][i] = valid ? sg[st][i] : 0.f;
          }
      }
      float T[4], Tp[4];
#pragma unroll
      for (int r = 0; r < 4; ++r) {
        const int st = r >> 1, o = (r & 1) * 8;
        T[r] = ((fz[st][o] * fz[st][o + 1]) * (fz[st][o + 2] * fz[st][o + 3])) * ((fz[st][o + 4] * fz[st][o + 5]) * (fz[st][o + 6] * fz[st][o + 7]));
        Tp[r] = __shfl_xor(T[r], 32);
      }
#pragma unroll
      for (int r = 3; r >= 0; --r) {
        const int st = r >> 1, o = (r & 1) * 8;
        float run = carry * (h == 0 ? Tp[r] : 1.f);
#pragma unroll
        for (int jj = 7; jj >= 0; --jj) {
          const float wv = sg[st][o + jj] * run;
          run *= fz[st][o + jj];
          sg[st][o + jj] = wv;
        }
        carry *= T[r] * Tp[r];
      }
      pv_half(Ks + 64 * KROW, sg[1], oacc, 1, hd, lane);
      pv_half(Ks + 64 * KROW, sg[0], oacc, 0, hd, lane);
      if (idx + 1 < ntiles) kv_store_bf16(smem + ((idx + 1) & 1) * KV_BUF, stg, t);
      int* flags = (int*)(smem + BIAS_OFF) + (idx & 1) * 8;
      const unsigned long long bal = __ballot(carry != 0.f);
      if (lane == 0) flags[w] = (bal != 0ull) ? 1 : 0;
      __syncthreads();
      const int alive = flags[0] | flags[1] | flags[2] | flags[3] | flags[4] | flags[5] | flags[6] | flags[7];
      if (!alive) break;
    }
    __syncthreads();
    gate_load(p, greg, tok0, head, lane);
    attn_stage(oacc, 1.f, lane, sw);
    int nxt = item + nb;
    if (nxt >= 2048) { const int g = bid >> 3; nxt = (item < 2048 && (g & 2) == 0) ? 2048 + (((g >> 2) * 2 + (g & 1)) * 2 + ((bid & 7) >> 2)) : 1 << 20; }
    const bool more = nxt < 2176;
    if (more) { decode(nxt); load_q(); load_tile(qt); }
    attn_flush(p, greg, tok0, head, lane, sw);
    __syncthreads();
    if (!more) break;
    item = nxt;
  }
}

DI void final_rows(const Params& p, int item) {
  const int t_ = tid(), lane = t_ & 63, w = t_ >> 6, row0 = item * 32 + w * 4;
  f32x4 v[4][4], g[4];
  float rstd[4];
#pragma unroll
  for (int r = 0; r < 4; ++r) {
    const bf16* y = (const bf16*)p.x1 + (size_t)(row0 + r) * 1024;
#pragma unroll
    for (int i = 0; i < 4; ++i) {
      const u32x2 q = __builtin_nontemporal_load((const u32x2*)(y + (i * 64 + lane) * 4));
      v[r][i] = f32x4{bf_lo(q.x), bf_hi(q.x), bf_lo(q.y), bf_hi(q.y)};
    }
  }
#pragma unroll
  for (int i = 0; i < 4; ++i) g[i] = *(const f32x4*)(p.norm_f + (i * 64 + lane) * 4);
#pragma unroll
  for (int r = 0; r < 4; ++r) {
    const f32x4* s4 = (const f32x4*)(p.ss2 + (size_t)(row0 + r) * 16);
    f32x4 a = s4[0], b = s4[1], c = s4[2], d = s4[3];
    const float sm = ((a.x + a.y) + (a.z + a.w)) + ((b.x + b.y) + (b.z + b.w)) + ((c.x + c.y) + (c.z + c.w)) + ((d.x + d.y) + (d.z + d.w));
    rstd[r] = __builtin_amdgcn_rsqf(sm * (1.f / 1024.f) + EPS);
  }
#pragma unroll
  for (int r = 0; r < 4; ++r) {
    float* y = p.out + (size_t)(row0 + r) * 1024;
#pragma unroll
    for (int i = 0; i < 4; ++i) {
      f32x4 o = {v[r][i].x * rstd[r] * g[i].x, v[r][i].y * rstd[r] * g[i].y, v[r][i].z * rstd[r] * g[i].z, v[r][i].w * rstd[r] * g[i].w};
      __builtin_nontemporal_store(o, (f32x4*)(y + (i * 64 + lane) * 4));
    }
  }
}

#define XB_TMO      128
#define XB_XCNT(j)  (256  + 64 * (j))
#define XB_XSUB(j)  (1280 + 64 * (j))
#define XB_XGEN(j)  (2304 + 64 * (j))
#define XB_TOP      3328
#define XB_TOPGEN   3392
#define XCD_BAR_WORDS 3456
#define XB_SPIN_CAP (1u << 18)
#define LAS __attribute__((address_space(3)))
DI unsigned xb_ld(unsigned* p)              { return __hip_atomic_load(p, __ATOMIC_RELAXED, __HIP_MEMORY_SCOPE_AGENT); }
DI unsigned xb_add(unsigned* p, unsigned v) { return __hip_atomic_fetch_add(p, v, __ATOMIC_RELAXED, __HIP_MEMORY_SCOPE_AGENT); }
DI unsigned xb_xcc_id() { return (unsigned)__builtin_amdgcn_s_getreg((3 << 11) | 20) & 0xFu; }
#define XB_SPIN(cond, bar) do { unsigned _sp = 0; while (cond) { __builtin_amdgcn_s_sleep(1); \
    if ((++_sp & 255u) == 0u) { if (xb_ld(&(bar)[XB_TMO])) break; if (_sp > XB_SPIN_CAP) { atomicAdd(&(bar)[XB_TMO], 1u); break; } } } } while (0)
struct XcdBarrier { unsigned* bar; unsigned x; volatile LAS unsigned* st; };
DI XcdBarrier xcd_barrier_post(unsigned* bar, volatile LAS unsigned* st) {
  XcdBarrier b; b.bar = bar; b.x = xb_xcc_id(); b.st = st;
  if (threadIdx.x == 0) (void)xb_add(&bar[XB_XCNT(b.x)], 1u);
  return b;
}
DI void xcd_barrier_complete(unsigned* bar, unsigned x, unsigned& nloc, unsigned& nx) {
  const unsigned G = gridDim.x * gridDim.y * gridDim.z;
  unsigned sum, cnt, mine, sp = 0u;
  for (;;) {
    sum = 0u; cnt = 0u; mine = 0u;
#pragma unroll
    for (unsigned j = 0; j < 16; ++j) { const unsigned c = xb_ld(&bar[XB_XCNT(j)]); sum += c; cnt += (c > 0u) ? 1u : 0u; mine = (j == x) ? c : mine; }
    if (sum == G) break;
    __builtin_amdgcn_s_sleep(1);
    if ((++sp & 255u) == 0u) { if (xb_ld(&bar[XB_TMO])) break; if (sp > XB_SPIN_CAP) { atomicAdd(&bar[XB_TMO], 1u); break; } }
  }
  nloc = mine > 0u ? mine : 1u; nx = cnt > 0u ? cnt : 1u;
}
DI void xcd_barrier(const XcdBarrier& b) {
  asm volatile("s_waitcnt vmcnt(0)" ::: "memory");
  __syncthreads();
  if (threadIdx.x == 0) {
    unsigned* bar = b.bar;
    __builtin_amdgcn_s_waitcnt(0);
    unsigned nloc = b.st[0], nx = b.st[1];
    if (nloc == 0u) { xcd_barrier_complete(bar, b.x, nloc, nx); b.st[0] = nloc; b.st[1] = nx; }
    const unsigned old = xb_add(&bar[XB_XSUB(b.x)], 1u);
    const unsigned gen = old / nloc;
    if (old + 1u == (gen + 1u) * nloc) {
      __builtin_amdgcn_fence(__ATOMIC_RELEASE, "agent");
      asm volatile("s_waitcnt vmcnt(0)" ::: "memory");
      const unsigned og = xb_add(&bar[XB_TOP], 1u);
      const unsigned tg = og / nx;
      if (og + 1u == (tg + 1u) * nx) xb_add(&bar[XB_TOPGEN], 1u);
      else XB_SPIN(xb_ld(&bar[XB_TOPGEN]) == tg, bar);
      __builtin_amdgcn_fence(__ATOMIC_ACQUIRE, "agent");
      xb_add(&bar[XB_XGEN(b.x)], 1u);
      asm volatile("s_waitcnt vmcnt(0)" ::: "memory");
    } else {
      XB_SPIN(xb_ld(&bar[XB_XGEN(b.x)]) == gen, bar);
      __builtin_amdgcn_fence(__ATOMIC_ACQUIRE, "agent");
      asm volatile("s_waitcnt vmcnt(0)" ::: "memory");
    }
  }
  __syncthreads();
}

__global__ void __launch_bounds__(NTHR) yoco_mega(Params p, int ph_lo, int ph_hi) {
  extern __shared__ __attribute__((aligned(16))) char smem[];
  const int bid = blockIdx.x, nb = gridDim.x;
  const bool fused = (ph_hi - ph_lo) > 1;
  volatile LAS unsigned* st = (volatile LAS unsigned*)(smem + XBST_OFF);
  XcdBarrier xb; xb.bar = p.bar; xb.x = 0; xb.st = st;
  if (fused) {
    if (threadIdx.x == 0) { st[0] = 0u; st[1] = 0u; }
    __syncthreads();
    xb = xcd_barrier_post(p.bar, st);
  }
  if (ph_hi < 0) cg::this_grid().sync();
  for (int pp = ph_lo * 2; pp < ph_hi * 2; ++pp) {
    const int ph = pp >> 1;
    if ((pp & 1) && !((DUP_MASK >> ph) & 1)) continue;
    switch (ph) {
      case 0:
        for (int i = bid; i < 2560; i += nb) prep_wtile(p, i, smem);
        for (int i = bid; i < MT / 32; i += nb) prep_xrows(p, i);
        break;
      case 1: {
        const bool gB = (bid >> 3) & 1;
        if (gB) { gemm_tile<1, 2>(p, 256 + (bid >> 4), bid & 15, false, -1, 0, smem); __syncthreads(); }
        {
          const int x8 = bid & 7, j8 = bid >> 3, tm0 = (x8 >> 1) * 4 + (j8 >> 3), tnn = (x8 & 1) * 8 + (j8 & 7);
          bool h0 = false;
#pragma unroll 1
          for (int r = 0; r < 8; ++r) { const int ok = r < 7; gemm_tile<1, 4>(p, r * 16 + tm0, tnn, h0, ok ? (r + 1) * 16 + tm0 : -1, tnn, smem); h0 = ok; }
        }
        if (!gB) { __syncthreads(); gemm_tile<1, 2>(p, 256 + (bid >> 4), bid & 15, false, -1, 0, smem); }
      } break;
      case 2: band_phase(p, smem, bid, nb); break;
      case 3: {
        const bool gB = (bid >> 3) & 1;
        const int jb = ((bid >> 4) << 3) | (bid & 7);
        if (gB) { gemm_tile<2, 1>(p, 512 + (jb >> 2), jb & 3, false, -1, 0, smem); __syncthreads(); }
        {
          const int tm0 = (bid & 7) * 8 + (bid >> 5), tnn = (bid >> 3) & 3;
          bool h0 = false;
#pragma unroll 1
          for (int r = 0; r < 4; ++r) { const int ok = r < 3; gemm_tile<2, 2>(p, r * 64 + tm0, tnn, h0, ok ? (r + 1) * 64 + tm0 : -1, tnn, smem); h0 = ok; }
        }
      } break;
      case 4: {
        const bool gB = (bid >> 3) & 1;
        if (gB) { gemm_tile<3, 2>(p, 256 + (bid >> 4), bid & 15, false, -1, 0, smem); __syncthreads(); }
        {
          const int x8 = bid & 7, j8 = bid >> 3, tm0 = (x8 >> 1) * 4 + (j8 >> 3), tnn = (x8 & 1) * 8 + (j8 & 7);
          bool h0 = false;
#pragma unroll 1
          for (int r = 0; r < 8; ++r) { const int ok = r < 7; gemm_tile<3, 4>(p, r * 16 + tm0, tnn, h0, ok ? (r + 1) * 16 + tm0 : -1, tnn, smem); h0 = ok; }
        }
        if (!gB) { __syncthreads(); gemm_tile<3, 2>(p, 256 + (bid >> 4), bid & 15, false, -1, 0, smem); }
      } break;
      case 5: sb_phase(p, smem, bid, nb); break;
      case 6: {
        const bool gB = (bid >> 3) & 1;
        const int jb = ((bid >> 4) << 3) | (bid & 7);
        if (gB) { gemm_tile<4, 1>(p, 512 + (jb >> 2), jb & 3, false, -1, 0, smem); __syncthreads(); }
        {
          const int tm0 = (bid & 7) * 8 + (bid >> 5), tnn = (bid >> 3) & 3;
          bool h0 = false;
#pragma unroll 1
          for (int r = 0; r < 4; ++r) { const int ok = r < 3; gemm_tile<4, 2>(p, r * 64 + tm0, tnn, h0, ok ? (r + 1) * 64 + tm0 : -1, tnn, smem); h0 = ok; }
        }
      } break;
      default: for (int i = bid; i < MT / 32; i += nb) final_rows(p, i); break;
    }
    if (pp + 1 < ph_hi * 2) xcd_barrier(xb);
  }
}

extern "C" void kernel_launch(void* const* d_in, const int* in_sizes, int n_in, void* d_out, int out_size,
                              void* d_ws, size_t ws_size, hipStream_t stream) {
  static int grid_blocks = 0;
  if (!grid_blocks) {
    int dev = 0, cus = 0, per_cu = 0;
    hipGetDevice(&dev);
    hipDeviceGetAttribute(&cus, hipDeviceAttributeMultiprocessorCount, dev);
    hipFuncSetAttribute((const void*)yoco_mega, hipFuncAttributeMaxDynamicSharedMemorySize, SMEM_BYTES);
    hipOccupancyMaxActiveBlocksPerMultiprocessor(&per_cu, yoco_mega, NTHR, SMEM_BYTES);
    if (per_cu < 1) per_cu = 1;
    grid_blocks = cus * per_cu;
    if (grid_blocks > 256) grid_blocks = 256;
  }
  Params p{};
  p.x_prompt = (const float*)d_in[0]; p.x_sample = (const float*)d_in[1];
  p.cache_a_k = (const float*)d_in[2]; p.cache_a_v = (const float*)d_in[3];
  p.cache_b_k = (const float*)d_in[4]; p.cache_b_v = (const float*)d_in[5];
  p.norm_a = (const float*)d_in[6]; p.w_in_a = (const float*)d_in[7]; p.rel_bias_a = (const float*)d_in[8];
  p.w_out_a = (const float*)d_in[9]; p.norm_kv = (const float*)d_in[10]; p.w_kv = (const float*)d_in[11];
  p.norm_b = (const float*)d_in[12]; p.w_in_b = (const float*)d_in[13]; p.w_out_b = (const float*)d_in[14];
  p.norm_f = (const float*)d_in[15];
  p.out = (float*)d_out;
  char* ws = (char*)d_ws;
  p.Wa = (bf16*)(ws + WS_WA); p.Woa = (bf16*)(ws + WS_WOA); p.Wb = (bf16*)(ws + WS_WB); p.Wob = (bf16*)(ws + WS_WOB);
  p.xb = (bf16*)(ws + WS_XB); p.qkvg = (bf16*)(ws + WS_QKVG); p.ao = (bf16*)(ws + WS_AO);
  p.x1 = (float*)(ws + WS_X1); p.ss0 = (float*)(ws + WS_SS0); p.ss1 = (float*)(ws + WS_SS1); p.ss2 = (float*)(ws + WS_SS2);
  p.bar = (unsigned*)(ws + WS_BAR);
#if ONE_LAUNCH
  hipMemsetAsync(p.bar, 0, XCD_BAR_WORDS * 4, stream);
  int lo = 0, hi = 8;
  void* args[] = {&p, &lo, &hi};
  hipError_t e = hipLaunchCooperativeKernel((const void*)yoco_mega, dim3(grid_blocks), dim3(NTHR), args, SMEM_BYTES, stream);
  if (e != hipSuccess) fprintf(stderr, "cooperative launch failed: %s (grid %d)\n", hipGetErrorString(e), grid_blocks);
#else
  for (int ph = 0; ph < 8; ++ph)
    hipLaunchKernelGGL(yoco_mega, dim3(grid_blocks), dim3(NTHR), SMEM_BYTES, stream, p, ph, ph + 1);
#endif
}
```

```cpp
#include <hip/hip_runtime.h>
#include <hip/hip_cooperative_groups.h>
#include <cstdio>
namespace cg = cooperative_groups;

#ifndef DUP_MASK
#define DUP_MASK 0
#endif
#ifndef ONE_LAUNCH
#define ONE_LAUNCH 1
#endif

typedef __bf16 bf16;
typedef __bf16 bf16x2 __attribute__((ext_vector_type(2)));
typedef __bf16 bf16x4 __attribute__((ext_vector_type(4)));
typedef __bf16 bf16x8 __attribute__((ext_vector_type(8)));
typedef float f32x2 __attribute__((ext_vector_type(2)));
typedef float f32x4 __attribute__((ext_vector_type(4)));
typedef float f32x16 __attribute__((ext_vector_type(16)));
typedef unsigned u32x2 __attribute__((ext_vector_type(2)));
typedef unsigned u32x4 __attribute__((ext_vector_type(4)));
typedef __attribute__((address_space(3))) bf16x4 lds_bf16x4;

#define DI __device__ __forceinline__
#define MFMA(a, b, c) __builtin_amdgcn_mfma_f32_32x32x16_bf16((a), (b), (c), 0, 0, 0)
#define MFMA16(a, b, c) __builtin_amdgcn_mfma_f32_16x16x32_bf16((a), (b), (c), 0, 0, 0)

constexpr int TP = 32768;
constexpr int MT = 34816;
constexpr float LOG2E = 1.4426950408889634f;
constexpr float QSCALE = 0.125f * LOG2E;
constexpr float EPS = 1e-6f;

constexpr size_t OFF_AKP = 35651584, OFF_AVP = 44040192, OFF_KBP = 52428800, OFF_VBP = 85983232;
constexpr size_t OFF_AKS = 119537664, OFF_AVS = 121634816, OFF_KBS = 123731968, OFF_VBS = 125829120;
constexpr size_t WS_WA = 0, WS_WOA = 8388608, WS_WB = 10485760, WS_WOB = 18874368, WS_XB = 20971520;
constexpr size_t WS_QKVG = 92274688, WS_AO = 377487360, WS_X1 = 448790528, WS_SS0 = 591396864;
constexpr size_t WS_SS1 = 591536128, WS_SS2 = 593764352, WS_BAR = 595992576;

constexpr int NTHR = 512;
constexpr int SMEM_BYTES = 147968;
constexpr int KROW = 528, VROW = 576;
constexpr int KV_BUF = 64 * KROW + 64 * VROW;
constexpr int BIAS_OFF = 2 * KV_BUF;
constexpr int XBST_OFF = 147952;
constexpr int RSTD_OFF = 136192;
constexpr int STG_ROW = 272, STG_WAVE = 32 * STG_ROW;

struct Params {
  const float *x_prompt, *x_sample, *cache_a_k, *cache_a_v, *cache_b_k, *cache_b_v;
  const float *norm_a, *w_in_a, *rel_bias_a, *w_out_a, *norm_kv, *w_kv, *norm_b, *w_in_b, *w_out_b, *norm_f;
  float* out;
  bf16 *Wa, *Woa, *Wb, *Wob, *xb, *qkvg, *ao;
  float *x1, *ss0, *ss1, *ss2;
  unsigned* bar;
};

DI unsigned pk(float a, float b) { f32x2 v = {a, b}; return __builtin_bit_cast(unsigned, __builtin_convertvector(v, bf16x2)); }
DI float bf_lo(unsigned u) { return __uint_as_float(u << 16); }
DI float bf_hi(unsigned u) { return __uint_as_float(u & 0xffff0000u); }
DI float silu(float x) { return x * __builtin_amdgcn_rcpf(1.f + __builtin_amdgcn_exp2f(-x * LOG2E)); }
DI int tid() { int t = threadIdx.x; asm volatile("" : "+v"(t)); return t; }
DI int pi_swap(int m) { return (m & ~12) | ((m & 4) << 1) | ((m & 8) >> 1); }

DI void prep_wtile(const Params& p, int item, char* smem) {
  float* lds = (float*)smem;
  const float* W; const float* g; bf16* Wt; int N, local;
  if (item < 1024)      { W = p.w_in_a;  N = 4096; g = p.norm_a;  Wt = p.Wa;  local = item; }
  else if (item < 1280) { W = p.w_out_a; N = 1024; g = nullptr;   Wt = p.Woa; local = item - 1024; }
  else if (item < 1792) { W = p.w_kv;    N = 2048; g = p.norm_kv; Wt = p.Wb;  local = item - 1280; }
  else if (item < 2304) { W = p.w_in_b;  N = 2048; g = p.norm_b;  Wt = p.Wb + (size_t)2048 * 1024; local = item - 1792; }
  else                  { W = p.w_out_b; N = 1024; g = nullptr;   Wt = p.Wob; local = item - 2304; }
  const int ntn = N >> 6, kt = local / ntn, nt = local % ntn, t = tid();
#pragma unroll
  for (int pass = 0; pass < 2; ++pass) {
    const int r = (t >> 4) + 32 * pass, c4 = (t & 15) * 4;
    f32x4 v = __builtin_nontemporal_load((const f32x4*)(W + (size_t)(kt * 64 + r) * N + nt * 64 + c4));
    const float gg = g ? g[kt * 64 + r] : 1.f;
    lds[r * 65 + c4 + 0] = v.x * gg; lds[r * 65 + c4 + 1] = v.y * gg;
    lds[r * 65 + c4 + 2] = v.z * gg; lds[r * 65 + c4 + 3] = v.w * gg;
  }
  __syncthreads();
  {
    const int n = t >> 3, kg = t & 7;
    u32x4 o;
    o.x = pk(lds[(8 * kg + 0) * 65 + n], lds[(8 * kg + 1) * 65 + n]);
    o.y = pk(lds[(8 * kg + 2) * 65 + n], lds[(8 * kg + 3) * 65 + n]);
    o.z = pk(lds[(8 * kg + 4) * 65 + n], lds[(8 * kg + 5) * 65 + n]);
    o.w = pk(lds[(8 * kg + 6) * 65 + n], lds[(8 * kg + 7) * 65 + n]);
    *(u32x4*)(Wt + (size_t)(nt * 64 + n) * 1024 + kt * 64 + 8 * kg) = o;
  }
  __syncthreads();
}

DI const float* xrow(const Params& p, int row) {
  return row < TP ? p.x_prompt + (size_t)row * 1024 : p.x_sample + (size_t)(row - TP) * 1024;
}

template <int NR>
DI void prep_xrows(const Params& p, int row0) {
  const int lane = tid() & 63;
  f32x4 v[NR][4];
#pragma unroll
  for (int r = 0; r < NR; ++r) {
    const float* x = xrow(p, row0 + r);
#pragma unroll
    for (int i = 0; i < 4; ++i) v[r][i] = __builtin_nontemporal_load((const f32x4*)(x + (i * 64 + lane) * 4));
  }
#pragma unroll
  for (int r = 0; r < NR; ++r) {
    float ss = 0.f;
#pragma unroll
    for (int i = 0; i < 4; ++i) {
      ss += v[r][i].x * v[r][i].x + v[r][i].y * v[r][i].y + v[r][i].z * v[r][i].z + v[r][i].w * v[r][i].w;
      u32x2 o = {pk(v[r][i].x, v[r][i].y), pk(v[r][i].z, v[r][i].w)};
      *(u32x2*)(p.xb + (size_t)(row0 + r) * 1024 + (i * 64 + lane) * 4) = o;
    }
#pragma unroll
    for (int m = 32; m >= 1; m >>= 1) ss += __shfl_xor(ss, m);
    if (lane == 0) p.ss0[row0 + r] = ss;
  }
}

DI void glds16(const void* gsrc, unsigned lds_dst) {
  unsigned keep;
  asm volatile("s_mov_b32 %0, m0\n\ts_mov_b32 m0, %2\n\ts_nop 0\n\tglobal_load_lds_dwordx4 %1, off\n\ts_mov_b32 m0, %0"
               : "=&s"(keep) : "v"(gsrc), "s"(lds_dst) : "memory");
}
template <int MODE, int TJ>
DI void gemm_tile(const Params& p, int tm, int tn, bool have0, int ntm, int ntn, char* smem) {
  const bf16* A = (MODE == 1 || MODE == 3) ? p.xb : p.ao;
  const bf16* W = MODE == 1 ? p.Wa : MODE == 2 ? p.Woa : MODE == 3 ? p.Wb : p.Wob;
  const int t = tid(), lane = t & 63, w = t >> 6, wn = w & 3, wm = w >> 2, l32 = lane & 31, h = lane >> 5;
  constexpr int XI = TJ;
  const int lc = (t & 7) ^ ((t >> 4) & 7);
  const bf16* Ag = A + (size_t)(tm * (TJ * 64) + (t >> 3)) * 1024 + lc * 8;
  const bf16* Wg = W + (size_t)(tn * 256 + (t >> 3)) * 1024 + lc * 8;
  const unsigned lds_w = __builtin_amdgcn_readfirstlane((unsigned)(size_t)smem + (unsigned)w * 1024u);
  const int crow = lane >> 4, cch = lane & 15;
  const int col0 = tn * 256 + wn * 64;
  const int l16 = lane & 15, q4 = lane >> 4;
  f32x4 acc[4][2 * TJ];
#pragma unroll
  for (int a = 0; a < 4; ++a)
#pragma unroll
    for (int b = 0; b < 2 * TJ; ++b)
#pragma unroll
      for (int i = 0; i < 4; ++i) acc[a][b][i] = 0.f;

  auto issue = [&](const bf16* ag, const bf16* wg, int kt, int buf) {
    const unsigned sb = lds_w + (unsigned)buf * 65536u;
#pragma unroll
    for (int i = 0; i < XI; ++i) glds16(ag + (size_t)(64 * i) * 1024 + kt * 64, sb + i * 8192u);
#pragma unroll
    for (int i = 0; i < 4; ++i) glds16(wg + (size_t)(64 * i) * 1024 + kt * 64, sb + 32768u + i * 8192u);
  };
  if (!have0) issue(Ag, Wg, 0, 0);
  const int swz = (l16 >> 1) & 7;
  int xa[2], wa[2];
#pragma unroll
  for (int s2 = 0; s2 < 2; ++s2) {
    const int off = (((4 * s2 + q4) ^ swz) * 16);
    xa[s2] = (wm * (TJ * 32) + l16) * 128 + off;
    wa[s2] = 32768 + (wn * 64 + l16) * 128 + off;
  }
  f32x4 sp0, sp1, sp2, sp3; float sp = 0.f;
  if (MODE == 1) { if (t < TJ * 64) sp = p.ss0[tm * (TJ * 64) + t]; }
  if (MODE == 3) {
    if (t < TJ * 64) {
      const f32x4* s4 = (const f32x4*)(p.ss1 + (size_t)(tm * (TJ * 64) + t) * 16);
      sp0 = s4[0]; sp1 = s4[1]; sp2 = s4[2]; sp3 = s4[3];
    }
  }
  asm volatile("s_waitcnt vmcnt(0)" ::: "memory");
  __syncthreads();
  issue(Ag, Wg, 1, 1);
  if (MODE == 1 || MODE == 3) {
    if (t < TJ * 64) {
      if (MODE == 3) sp = ((sp0.x + sp0.y) + (sp0.z + sp0.w)) + ((sp1.x + sp1.y) + (sp1.z + sp1.w)) + ((sp2.x + sp2.y) + (sp2.z + sp2.w)) + ((sp3.x + sp3.y) + (sp3.z + sp3.w));
      ((float*)(smem + RSTD_OFF))[t] = __builtin_amdgcn_rsqf(sp * (1.f / 1024.f) + EPS);
    }
  }
  f32x4 rres[(MODE == 2 || MODE == 4) ? TJ : 1][8];
  bf16x8 wfr[4], ax[TJ], bx[TJ];
  auto ldx = [&](int s2, int uh, const char* base, bf16x8* fx) {
#pragma unroll
    for (int uu = 0; uu < TJ; ++uu) fx[uu] = *(const bf16x8*)(base + xa[s2] + (uh * TJ + uu) * 2048);
  };
  auto mma_all = [&](int uh, const bf16x8* fx) {
    __builtin_amdgcn_sched_barrier(0);
#pragma unroll
    for (int uu = 0; uu < TJ; ++uu)
#pragma unroll
      for (int f = 0; f < 4; ++f) acc[f][uh * TJ + uu] = MFMA16(wfr[f], fx[uu], acc[f][uh * TJ + uu]);
    __builtin_amdgcn_sched_barrier(0);
  };
  auto mma_refresh = [&](int uh, const bf16x8* fx, const char* wbase, int s2, bool reload) {
#pragma unroll
    for (int f = 0; f < 4; ++f) {
      __builtin_amdgcn_sched_barrier(0);
#pragma unroll
      for (int uu = 0; uu < TJ; ++uu) acc[f][uh * TJ + uu] = MFMA16(wfr[f], fx[uu], acc[f][uh * TJ + uu]);
      __builtin_amdgcn_sched_barrier(0);
      if (reload) wfr[f] = *(const bf16x8*)(wbase + wa[s2] + f * 2048);
    }
  };
#pragma unroll
  for (int f = 0; f < 4; ++f) wfr[f] = *(const bf16x8*)(smem + wa[0] + f * 2048);
  ldx(0, 0, smem, ax);
  for (int kt = 0; kt < 16; ++kt) {
    const char* base = smem + (kt & 1) * 65536;
    const char* nbase = smem + ((kt + 1) & 1) * 65536;
    ldx(0, 1, base, bx); mma_all(0, ax);
    ldx(1, 0, base, ax); mma_refresh(1, bx, base, 1, true);
    ldx(1, 1, base, bx); mma_all(0, ax);
    if (kt < 15) {
      asm volatile("s_waitcnt vmcnt(0) lgkmcnt(0)" ::: "memory");
      __syncthreads();
      if (kt < 14) issue(Ag, Wg, kt + 2, kt & 1);
      if ((MODE == 2 || MODE == 4) && kt == 0) {
#pragma unroll
        for (int tj = 0; tj < TJ; ++tj) {
          const int tok0 = tm * (TJ * 64) + wm * (TJ * 32) + tj * 32;
          if (MODE == 2) {
            const float* res = xrow(p, tok0) + col0 + 4 * cch;
#pragma unroll
            for (int ps = 0; ps < 8; ++ps) rres[tj][ps] = __builtin_nontemporal_load((const f32x4*)(res + (size_t)(crow + 4 * ps) * 1024));
          } else {
            const bf16* res = p.xb + (size_t)tok0 * 1024 + col0 + 4 * cch;
#pragma unroll
            for (int ps = 0; ps < 8; ++ps) {
              const u32x2 r2 = __builtin_nontemporal_load((const u32x2*)(res + (size_t)(crow + 4 * ps) * 1024));
              rres[tj][ps] = f32x4{__uint_as_float(r2.x), __uint_as_float(r2.y), 0.f, 0.f};
            }
          }
        }
      }
      ldx(0, 0, nbase, ax);
    }
    mma_refresh(1, bx, nbase, 0, kt < 15);
  }
  if (ntm >= 0) {
    const bf16* nAg = A + (size_t)(ntm * (TJ * 64) + (t >> 3)) * 1024 + lc * 8;
    const bf16* nWg = W + (size_t)(ntn * 256 + (t >> 3)) * 1024 + lc * 8;
    issue(nAg, nWg, 0, 0);
  }
  asm volatile("s_waitcnt lgkmcnt(0)" ::: "memory");
  __syncthreads();

  char* sw = smem + 65536 + w * STG_WAVE;
#pragma unroll
  for (int tj = 0; tj < TJ; ++tj) {
    const int tok0 = tm * (TJ * 64) + wm * (TJ * 32) + tj * 32;
    if (MODE == 1 || MODE == 3) {
      const int type = tn >> 2;
      constexpr int QT = (MODE == 1) ? 0 : 2;
#pragma unroll
      for (int u2 = 0; u2 < 2; ++u2) {
        const float rstd = ((const float*)(smem + RSTD_OFF))[wm * (TJ * 32) + tj * 32 + 16 * u2 + l16];
        const float mul = (type == QT) ? rstd * QSCALE : rstd;
#pragma unroll
        for (int f = 0; f < 4; ++f) {
          f32x4 v = acc[f][2 * tj + u2] * mul;
          if (type == 3) { v.x = silu(v.x); v.y = silu(v.y); v.z = silu(v.z); v.w = silu(v.w); }
          *(f32x4*)(sw + (16 * u2 + l16) * STG_ROW + (16 * f + 4 * q4) * 4) = v;
        }
      }
      asm volatile("s_waitcnt lgkmcnt(0)" ::: "memory");
      float* fout = nullptr;
      const int c = (col0 & 1023) + 4 * cch;
      if (MODE == 1) {
        if (type == 1 || type == 2) {
          if (tok0 < TP) { const int tt = tok0 & 2047; if (tt >= 1536) fout = p.out + (type == 1 ? OFF_AKP : OFF_AVP) + ((size_t)((tok0 >> 11) * 512 + tt - 1536)) * 1024 + c; }
          else fout = p.out + (type == 1 ? OFF_AKS : OFF_AVS) + (size_t)(tok0 - TP) * 1024 + c;
        }
      } else {
        if (type == 0 || type == 1) {
          if (tok0 < TP) fout = p.out + (type == 0 ? OFF_KBP : OFF_VBP) + (size_t)tok0 * 1024 + c;
          else fout = p.out + (type == 0 ? OFF_KBS : OFF_VBS) + (size_t)(tok0 - TP) * 1024 + c;
        }
      }
      bf16* bout = p.qkvg + (size_t)tok0 * 4096 + col0 + 4 * cch;
      f32x4 vb[8];
#pragma unroll
      for (int ps = 0; ps < 8; ++ps) vb[ps] = *(const f32x4*)(sw + (crow + 4 * ps) * STG_ROW + cch * 16);
      asm volatile("s_waitcnt lgkmcnt(0)" ::: "memory");
#pragma unroll
      for (int ps = 0; ps < 8; ++ps) {
        const int row = crow + 4 * ps;
        u32x2 o = {pk(vb[ps].x, vb[ps].y), pk(vb[ps].z, vb[ps].w)};
        *(u32x2*)(bout + (size_t)row * 4096) = o;
      }
      if (fout) {
#pragma unroll
        for (int ps = 0; ps < 8; ++ps) __builtin_nontemporal_store(vb[ps], (f32x4*)(fout + (size_t)(crow + 4 * ps) * 1024));
      }
    } else {
#pragma unroll
      for (int ps = 0; ps < 8; ++ps) {
        f32x4 r = rres[tj][ps];
        if (MODE == 4) { const unsigned a = __float_as_uint(r.x), b2 = __float_as_uint(r.y); r = f32x4{bf_lo(a), bf_hi(a), bf_lo(b2), bf_hi(b2)}; }
        *(f32x4*)(sw + (crow + 4 * ps) * STG_ROW + cch * 16) = r;
      }
      asm volatile("s_waitcnt lgkmcnt(0)" ::: "memory");
      float ssq[2] = {0.f, 0.f};
#pragma unroll
      for (int u2 = 0; u2 < 2; ++u2)
#pragma unroll
        for (int f = 0; f < 4; ++f) {
          f32x4* q = (f32x4*)(sw + (16 * u2 + l16) * STG_ROW + (16 * f + 4 * q4) * 4);
          const f32x4 y = *q + acc[f][2 * tj + u2];
          ssq[u2] += y.x * y.x + y.y * y.y + y.z * y.z + y.w * y.w;
          *q = y;
        }
      asm volatile("s_waitcnt lgkmcnt(0)" ::: "memory");
      float* ssd = (MODE == 2) ? p.ss1 : p.ss2;
#pragma unroll
      for (int u2 = 0; u2 < 2; ++u2) {
        float sv = ssq[u2];
        sv += __shfl_xor(sv, 16);
        sv += __shfl_xor(sv, 32);
        if (q4 == 0) ssd[(size_t)(tok0 + 16 * u2 + l16) * 16 + tn * 4 + wn] = sv;
      }
      bf16* bo = ((MODE == 2) ? p.xb : (bf16*)p.x1) + (size_t)tok0 * 1024 + col0 + 4 * cch;
      f32x4 yb[8];
#pragma unroll
      for (int ps = 0; ps < 8; ++ps) yb[ps] = *(const f32x4*)(sw + (crow + 4 * ps) * STG_ROW + cch * 16);
      asm volatile("s_waitcnt lgkmcnt(0)" ::: "memory");
#pragma unroll
      for (int ps = 0; ps < 8; ++ps) { u32x2 o = {pk(yb[ps].x, yb[ps].y), pk(yb[ps].z, yb[ps].w)}; *(u32x2*)(bo + (size_t)(crow + 4 * ps) * 1024) = o; }
    }
    asm volatile("s_waitcnt lgkmcnt(0)" ::: "memory");
  }
}

DI void kv_load_bf16(const bf16* kb, const bf16* vb, u32x4* stg, int t) {
#pragma unroll
  for (int i = 0; i < 4; ++i) stg[i] = *(const u32x4*)(kb + (size_t)((t >> 5) + 16 * i) * 4096 + (t & 31) * 8);
#pragma unroll
  for (int i = 0; i < 4; ++i) stg[4 + i] = *(const u32x4*)(vb + (size_t)((t >> 5) + 16 * i) * 4096 + (t & 31) * 8);
}
DI void kv_store_bf16(char* Ks, const u32x4* stg, int t) {
  char* Vs = Ks + 64 * KROW;
#pragma unroll
  for (int i = 0; i < 4; ++i) *(u32x4*)(Ks + ((t >> 5) + 16 * i) * KROW + (t & 31) * 16) = stg[i];
#pragma unroll
  for (int i = 0; i < 4; ++i) *(u32x4*)(Vs + ((t >> 5) + 16 * i) * VROW + (t & 31) * 16) = stg[4 + i];
}
DI void kv_load_f32(const float* kf, const float* vf, u32x4* stg, int t) {
#pragma unroll
  for (int i = 0; i < 4; ++i) {
    const float* a = kf + (size_t)((t >> 5) + 16 * i) * 1024 + (t & 31) * 8;
    f32x4 v0 = __builtin_nontemporal_load((const f32x4*)a), v1 = __builtin_nontemporal_load((const f32x4*)(a + 4));
    u32x4 o = {pk(v0.x, v0.y), pk(v0.z, v0.w), pk(v1.x, v1.y), pk(v1.z, v1.w)};
    stg[i] = o;
  }
#pragma unroll
  for (int i = 0; i < 4; ++i) {
    const float* a = vf + (size_t)((t >> 5) + 16 * i) * 1024 + (t & 31) * 8;
    f32x4 v0 = __builtin_nontemporal_load((const f32x4*)a), v1 = __builtin_nontemporal_load((const f32x4*)(a + 4));
    u32x4 o = {pk(v0.x, v0.y), pk(v0.z, v0.w), pk(v1.x, v1.y), pk(v1.z, v1.w)};
    stg[4 + i] = o;
  }
}

DI void qk_half(const char* Ks, const bf16x8* qf, f32x16& sacc, int st, int hd, int l32, int h) {
  const int prow = pi_swap(l32);
#pragma unroll
  for (int i = 0; i < 16; ++i) sacc[i] = 0.f;
#pragma unroll
  for (int s = 0; s < 4; ++s) {
    bf16x8 kf = *(const bf16x8*)(Ks + (32 * st + prow) * KROW + (hd * 64 + 16 * s + 8 * h) * 2);
    sacc = MFMA(kf, qf[s], sacc);
  }
}
DI void pv_half(const char* Vs, const f32x16& pw, f32x16* oacc, int st, int hd, int lane) {
  const int h = lane >> 5, qd = (lane & 15) >> 2, blk = (lane >> 4) & 1, pp = lane & 3;
  const char* vbase = Vs + (32 * st + 8 * h + qd) * VROW + hd * 128 + blk * 32 + pp * 8;
#pragma unroll
  for (int ss = 0; ss < 2; ++ss) {
    u32x4 pu = {pk(pw[8 * ss + 0], pw[8 * ss + 1]), pk(pw[8 * ss + 2], pw[8 * ss + 3]),
                pk(pw[8 * ss + 4], pw[8 * ss + 5]), pk(pw[8 * ss + 6], pw[8 * ss + 7])};
    bf16x8 pf = __builtin_bit_cast(bf16x8, pu);
#pragma unroll
    for (int dt = 0; dt < 2; ++dt) {
      const char* a = vbase + (16 * ss) * VROW + dt * 64;
      bf16x4 lo = __builtin_amdgcn_ds_read_tr16_b64_v4bf16((lds_bf16x4*)(a));
      bf16x4 hi = __builtin_amdgcn_ds_read_tr16_b64_v4bf16((lds_bf16x4*)(a + 4 * VROW));
      bf16x8 vf = __builtin_shufflevector(lo, hi, 0, 1, 2, 3, 4, 5, 6, 7);
      oacc[dt] = MFMA(vf, pf, oacc[dt]);
    }
  }
}
DI void attn_stage(const f32x16* oacc, float scale, int lane, char* sw) {
  const int l32 = lane & 31, h = lane >> 5;
#pragma unroll
  for (int dt = 0; dt < 2; ++dt)
#pragma unroll
    for (int g = 0; g < 4; ++g) {
      f32x4 v = {oacc[dt][4 * g + 0] * scale, oacc[dt][4 * g + 1] * scale, oacc[dt][4 * g + 2] * scale, oacc[dt][4 * g + 3] * scale};
      *(f32x4*)(sw + l32 * STG_ROW + (dt * 32 + 8 * g + 4 * h) * 4) = v;
    }
  asm volatile("s_waitcnt lgkmcnt(0)" ::: "memory");
}
DI void gate_load(const Params& p, u32x2* greg, int tok0, int head, int lane) {
  const bf16* gsrc = p.qkvg + (size_t)tok0 * 4096 + 3072 + head * 64 + 4 * (lane & 15);
#pragma unroll
  for (int ps = 0; ps < 8; ++ps) greg[ps] = __builtin_nontemporal_load((const u32x2*)(gsrc + (size_t)((lane >> 4) + 4 * ps) * 4096));
}
DI void attn_flush(const Params& p, const u32x2* greg, int tok0, int head, int lane, const char* sw) {
  const int crow = lane >> 4, cch = lane & 15;
  bf16* dst = p.ao + (size_t)tok0 * 1024 + head * 64 + 4 * cch;
#pragma unroll
  for (int ps = 0; ps < 8; ++ps) {
    const int row = crow + 4 * ps;
    f32x4 v = *(const f32x4*)(sw + row * STG_ROW + cch * 16);
    u32x2 sg = greg[ps];
    u32x2 o = {pk(v.x * bf_lo(sg.x), v.y * bf_hi(sg.x)), pk(v.z * bf_lo(sg.y), v.w * bf_hi(sg.y))};
    *(u32x2*)(dst + (size_t)row * 1024) = o;
  }
}

DI void band_phase(const Params& p, char* smem, int bid, int nb) {
  const int t = tid(), lane = t & 63, w = t >> 6, hd = w >> 1, qsub = w & 1, l32 = lane & 31, h = lane >> 5;
  const int hp = bid & 3, head = hp * 4 + hd;
  float* bias = (float*)(smem + BIAS_OFF);
  for (int i = t; i < 4 * 320; i += NTHR) {
    const int hh = i / 320, r = i % 320;
    bias[hh * 320 + r] = p.rel_bias_a[(hp * 4 + hh) * 257 + (r > 256 ? 256 : r)] * LOG2E;
  }
  const float* bh = bias + hd * 320;
  char* sw = smem + w * STG_WAVE;
  int item = bid;
  if (item >= 2176) return;
  int b, c, qrow0, ntiles; bool sample;
  auto decode = [&](int it) {
    sample = it >= 2048;
    if (!sample) { const int x = it & 7; c = (((it >> 3) & 31) + 4 * (it >> 8)) & 31; b = (it >> 8) * 2 + (x >> 2); qrow0 = b * 2048 + c * 64; ntiles = (c < 8 ? c : 8) + 1; }
    else { b = it - 2048; c = 8; qrow0 = TP + b * 64; ntiles = 9; }
  };
  bf16x8 qf[4];
  u32x4 stg[8];
  auto load_q = [&]() {
    const bf16* q = p.qkvg + (size_t)(qrow0 + qsub * 32 + l32) * 4096 + head * 64 + 8 * h;
#pragma unroll
    for (int s2 = 0; s2 < 4; ++s2) qf[s2] = *(const bf16x8*)(q + 16 * s2);
  };
  auto load_tile = [&](int j) {
    if (!sample) {
      const bf16* kb = p.qkvg + (size_t)(b * 2048 + j * 64) * 4096 + 1024 + hp * 256;
      kv_load_bf16(kb, kb + 1024, stg, t);
    } else if (j < 8) {
      const size_t o = (size_t)(b * 512 + j * 64) * 1024 + hp * 256;
      kv_load_f32(p.cache_a_k + o, p.cache_a_v + o, stg, t);
    } else {
      const bf16* kb = p.qkvg + (size_t)(TP + b * 64) * 4096 + 1024 + hp * 256;
      kv_load_bf16(kb, kb + 1024, stg, t);
    }
  };
  decode(item);
  load_q(); load_tile(c + 1 - ntiles);
  for (;;) {
    const int j0 = c + 1 - ntiles, tok0 = qrow0 + qsub * 32;
    kv_store_bf16(smem, stg, t);
    __syncthreads();
    f32x16 oacc[2];
#pragma unroll
    for (int d = 0; d < 2; ++d)
#pragma unroll
      for (int i = 0; i < 16; ++i) oacc[d][i] = 0.f;
    float m_run = -1e30f, l_run = 0.f;
    u32x2 greg[8];
    for (int idx = 0; idx < ntiles; ++idx) {
      const int j = j0 + idx;
      if (idx + 1 < ntiles) load_tile(j + 1);
      __builtin_amdgcn_sched_barrier(0);
      const char* Ks = smem + (idx & 1) * KV_BUF;
      const int dj = c - j;
      const float cb = bh[256];
      const int idx0 = dj * 64 + qsub * 32 + l32 - 8 * h;
      f32x16 sacc[2];
      qk_half(Ks, qf, sacc[0], 0, hd, l32, h);
      qk_half(Ks, qf, sacc[1], 1, hd, l32, h);
      if (dj >= 3) {
#pragma unroll
        for (int st = 0; st < 2; ++st)
#pragma unroll
          for (int i = 0; i < 16; ++i) sacc[st][i] += cb;
      } else {
#pragma unroll
        for (int st = 0; st < 2; ++st)
#pragma unroll
          for (int i = 0; i < 16; ++i) sacc[st][i] += bh[idx0 + 128 - (32 * st + 16 * (i >> 3) + (i & 7))];
      }
      float mx0 = sacc[0][0], mx1 = sacc[1][0];
#pragma unroll
      for (int i = 1; i < 16; ++i) { mx0 = fmaxf(mx0, sacc[0][i]); mx1 = fmaxf(mx1, sacc[1][i]); }
      float mx = fmaxf(mx0, mx1);
      mx = fmaxf(mx, __shfl_xor(mx, 32));
      const float m_new = fmaxf(m_run, mx);
      const float alpha = __builtin_amdgcn_exp2f(m_run - m_new);
      m_run = m_new;
      float ls0 = 0.f, ls1 = 0.f;
#pragma unroll
      for (int i = 0; i < 16; ++i) {
        const float e0 = __builtin_amdgcn_exp2f(sacc[0][i] - m_new); sacc[0][i] = e0; ls0 += e0;
        const float e1 = __builtin_amdgcn_exp2f(sacc[1][i] - m_new); sacc[1][i] = e1; ls1 += e1;
      }
      l_run = l_run * alpha + (ls0 + ls1);
      if (__ballot(alpha != 1.f) != 0ull) {
#pragma unroll
        for (int d = 0; d < 2; ++d)
#pragma unroll
          for (int i = 0; i < 16; ++i) oacc[d][i] *= alpha;
      }
      pv_half(Ks + 64 * KROW, sacc[0], oacc, 0, hd, lane);
      pv_half(Ks + 64 * KROW, sacc[1], oacc, 1, hd, lane);
      if (idx + 1 < ntiles) kv_store_bf16(smem + ((idx + 1) & 1) * KV_BUF, stg, t);
      __syncthreads();
    }
    gate_load(p, greg, tok0, head, lane);
    const float l = l_run + __shfl_xor(l_run, 32);
    attn_stage(oacc, 1.f / l, lane, sw);
    int nxt = item + nb;
    if (nxt >= 2048) { const int g = bid >> 3; nxt = (item < 2048 && (g & 2) == 0) ? 2048 + (((g >> 2) * 2 + (g & 1)) * 2 + ((bid & 7) >> 2)) : 1 << 20; }
    const bool more = nxt < 2176;
    if (more) { decode(nxt); load_q(); load_tile(c + 1 - ntiles); }
    attn_flush(p, greg, tok0, head, lane, sw);
    __syncthreads();
    if (!more) break;
    item = nxt;
  }
}

DI void sb_phase(const Params& p, char* smem, int bid, int nb) {
  const int t = tid(), lane = t & 63, w = t >> 6, hd = w >> 1, qsub = w & 1, l32 = lane & 31, h = lane >> 5;
  const int hp = bid & 3, head = hp * 4 + hd;
  char* sw = smem + w * STG_WAVE;
  int item = bid;
  if (item >= 2176) return;
  int b, qt, qrow0, ntiles; bool sample;
  auto decode = [&](int it) {
    sample = it >= 2048;
    if (!sample) { const int x = it & 7; qt = 31 - ((((it >> 3) & 31) + 4 * (it >> 8)) & 31); b = (it >> 8) * 2 + (x >> 2); qrow0 = b * 2048 + qt * 64; ntiles = qt + 1; }
    else { b = it - 2048; qt = 32; qrow0 = TP + b * 64; ntiles = 33; }
  };
  bf16x8 qf[4];
  u32x4 stg[8];
  auto load_q = [&]() {
    const bf16* q = p.qkvg + (size_t)(qrow0 + qsub * 32 + l32) * 4096 + 2048 + head * 64 + 8 * h;
#pragma unroll
    for (int s2 = 0; s2 < 4; ++s2) qf[s2] = *(const bf16x8*)(q + 16 * s2);
  };
  auto load_tile = [&](int kt) {
    if (!sample) {
      const bf16* kb = p.qkvg + (size_t)(b * 2048 + kt * 64) * 4096 + hp * 256;
      kv_load_bf16(kb, kb + 1024, stg, t);
    } else if (kt == 32) {
      const bf16* kb = p.qkvg + (size_t)(TP + b * 64) * 4096 + hp * 256;
      kv_load_bf16(kb, kb + 1024, stg, t);
    } else {
      const size_t o = (size_t)(b * 2048 + kt * 64) * 1024 + hp * 256;
      kv_load_f32(p.cache_b_k + o, p.cache_b_v + o, stg, t);
    }
  };
  decode(item);
  load_q(); load_tile(qt);
  for (;;) {
    const int tok0 = qrow0 + qsub * 32;
    kv_store_bf16(smem, stg, t);
    __syncthreads();
    f32x16 oacc[2];
#pragma unroll
    for (int d = 0; d < 2; ++d)
#pragma unroll
      for (int i = 0; i < 16; ++i) oacc[d][i] = 0.f;
    float carry = 1.f;
    const int qlim = qsub * 32 + l32 - 8 * h;
    u32x2 greg[8];
    for (int idx = 0; idx < ntiles; ++idx) {
      const int kt = qt - idx;
      if (idx + 1 < ntiles) load_tile(kt - 1);
      __builtin_amdgcn_sched_barrier(0);
      const char* Ks = smem + (idx & 1) * KV_BUF;
      const bool diag = (idx == 0);
      f32x16 fz[2], sg[2];
      qk_half(Ks, qf, fz[1], 1, hd, l32, h);
      qk_half(Ks, qf, fz[0], 0, hd, l32, h);
#pragma unroll
      for (int st = 0; st < 2; ++st)
#pragma unroll
        for (int i = 0; i < 16; ++i) {
          const float e = __builtin_amdgcn_exp2f(fminf(fz[st][i], 100.f));
          const float f = __builtin_amdgcn_rcpf(1.f + e);
          fz[st][i] = f; sg[st][i] = e * f;
        }
      if (diag) {
#pragma unroll
        for (int st = 0; st < 2; ++st)
#pragma unroll
          for (int i = 0; i < 16; ++i) {
            const bool valid = (32 * st + 16 * (i >> 3) + (i & 7)) < qlim;
            fz[st][i] = valid ? fz[st][i] : 1.f; sg[st][i] = valid ? sg[st][i] : 0.f;
          }
      }
      float T[4], Tp[4];
#pragma unroll
      for (int r = 0; r < 4; ++r) {
        const int st = r >> 1, o = (r & 1) * 8;
        T[r] = ((fz[st][o] * fz[st][o + 1]) * (fz[st][o + 2] * fz[st][o + 3])) * ((fz[st][o + 4] * fz[st][o + 5]) * (fz[st][o + 6] * fz[st][o + 7]));
        Tp[r] = __shfl_xor(T[r], 32);
      }
#pragma unroll
      for (int r = 3; r >= 0; --r) {
        const int st = r >> 1, o = (r & 1) * 8;
        float run = carry * (h == 0 ? Tp[r] : 1.f);
#pragma unroll
        for (int jj = 7; jj >= 0; --jj) {
          const float wv = sg[st][o + jj] * run;
          run *= fz[st][o + jj];
          sg[st][o + jj] = wv;
        }
        carry *= T[r] * Tp[r];
      }
      pv_half(Ks + 64 * KROW, sg[1], oacc, 1, hd, lane);
      pv_half(Ks + 64 * KROW, sg[0], oacc, 0, hd, lane);
      if (idx + 1 < ntiles) kv_store_bf16(smem + ((idx + 1) & 1) * KV_BUF, stg, t);
      int* flags = (int*)(smem + BIAS_OFF) + (idx & 1) * 8;
      const unsigned long long bal = __ballot(carry != 0.f);
      if (lane == 0) flags[w] = (bal != 0ull) ? 1 : 0;
      __syncthreads();
      const int alive = flags[0] | flags[1] | flags[2] | flags[3] | flags[4] | flags[5] | flags[6] | flags[7];
      if (!alive) break;
    }
    __syncthreads();
    gate_load(p, greg, tok0, head, lane);
    attn_stage(oacc, 1.f, lane, sw);
    int nxt = item + nb;
    if (nxt >= 2048) { const int g = bid >> 3; nxt = (item < 2048 && (g & 2) == 0) ? 2048 + (((g >> 2) * 2 + (g & 1)) * 2 + ((bid & 7) >> 2)) : 1 << 20; }
    const bool more = nxt < 2176;
    if (more) { decode(nxt); load_q(); load_tile(qt); }
    attn_flush(p, greg, tok0, head, lane, sw);
    __syncthreads();
    if (!more) break;
    item = nxt;
  }
}

template <int NR>
DI void final_rows(const Params& p, int row0) {
  const int lane = tid() & 63;
  f32x4 v[NR][4], g[4];
  float rstd[NR];
#pragma unroll
  for (int r = 0; r < NR; ++r) {
    const bf16* y = (const bf16*)p.x1 + (size_t)(row0 + r) * 1024;
#pragma unroll
    for (int i = 0; i < 4; ++i) {
      const u32x2 q = __builtin_nontemporal_load((const u32x2*)(y + (i * 64 + lane) * 4));
      v[r][i] = f32x4{bf_lo(q.x), bf_hi(q.x), bf_lo(q.y), bf_hi(q.y)};
    }
  }
#pragma unroll
  for (int i = 0; i < 4; ++i) g[i] = *(const f32x4*)(p.norm_f + (i * 64 + lane) * 4);
#pragma unroll
  for (int r = 0; r < NR; ++r) {
    const f32x4* s4 = (const f32x4*)(p.ss2 + (size_t)(row0 + r) * 16);
    f32x4 a = s4[0], b = s4[1], c = s4[2], d = s4[3];
    const float sm = ((a.x + a.y) + (a.z + a.w)) + ((b.x + b.y) + (b.z + b.w)) + ((c.x + c.y) + (c.z + c.w)) + ((d.x + d.y) + (d.z + d.w));
    rstd[r] = __builtin_amdgcn_rsqf(sm * (1.f / 1024.f) + EPS);
  }
#pragma unroll
  for (int r = 0; r < NR; ++r) {
    float* y = p.out + (size_t)(row0 + r) * 1024;
#pragma unroll
    for (int i = 0; i < 4; ++i) {
      f32x4 o = {v[r][i].x * rstd[r] * g[i].x, v[r][i].y * rstd[r] * g[i].y, v[r][i].z * rstd[r] * g[i].z, v[r][i].w * rstd[r] * g[i].w};
      __builtin_nontemporal_store(o, (f32x4*)(y + (i * 64 + lane) * 4));
    }
  }
}

#define XB_TMO      128
#define XB_XCNT(j)  (256  + 64 * (j))
#define XB_XSUB(j)  (1280 + 64 * (j))
#define XB_XGEN(j)  (2304 + 64 * (j))
#define XB_TOP      3328
#define XB_TOPGEN   3392
#define XCD_BAR_WORDS 3456
#define XB_SPIN_CAP (1u << 18)
#define LAS __attribute__((address_space(3)))
DI unsigned xb_ld(unsigned* p)              { return __hip_atomic_load(p, __ATOMIC_RELAXED, __HIP_MEMORY_SCOPE_AGENT); }
DI unsigned xb_add(unsigned* p, unsigned v) { return __hip_atomic_fetch_add(p, v, __ATOMIC_RELAXED, __HIP_MEMORY_SCOPE_AGENT); }
DI unsigned xb_xcc_id() { return (unsigned)__builtin_amdgcn_s_getreg((3 << 11) | 20) & 0xFu; }
#define XB_SPIN(cond, bar) do { unsigned _sp = 0; while (cond) { __builtin_amdgcn_s_sleep(1); \
    if ((++_sp & 255u) == 0u) { if (xb_ld(&(bar)[XB_TMO])) break; if (_sp > XB_SPIN_CAP) { atomicAdd(&(bar)[XB_TMO], 1u); break; } } } } while (0)
struct XcdBarrier { unsigned* bar; unsigned x; volatile LAS unsigned* st; };
DI XcdBarrier xcd_barrier_post(unsigned* bar, volatile LAS unsigned* st) {
  XcdBarrier b; b.bar = bar; b.x = xb_xcc_id(); b.st = st;
  if (threadIdx.x == 0) (void)xb_add(&bar[XB_XCNT(b.x)], 1u);
  return b;
}
DI void xcd_barrier_complete(unsigned* bar, unsigned x, unsigned& nloc, unsigned& nx) {
  const unsigned G = gridDim.x * gridDim.y * gridDim.z;
  unsigned sum, cnt, mine, sp = 0u;
  for (;;) {
    sum = 0u; cnt = 0u; mine = 0u;
#pragma unroll
    for (unsigned j = 0; j < 16; ++j) { const unsigned c = xb_ld(&bar[XB_XCNT(j)]); sum += c; cnt += (c > 0u) ? 1u : 0u; mine = (j == x) ? c : mine; }
    if (sum == G) break;
    __builtin_amdgcn_s_sleep(1);
    if ((++sp & 255u) == 0u) { if (xb_ld(&bar[XB_TMO])) break; if (sp > XB_SPIN_CAP) { atomicAdd(&bar[XB_TMO], 1u); break; } }
  }
  nloc = mine > 0u ? mine : 1u; nx = cnt > 0u ? cnt : 1u;
}
DI void xcd_barrier(const XcdBarrier& b) {
  asm volatile("s_waitcnt vmcnt(0)" ::: "memory");
  __syncthreads();
  if (threadIdx.x == 0) {
    unsigned* bar = b.bar;
    __builtin_amdgcn_s_waitcnt(0);
    unsigned nloc = b.st[0], nx = b.st[1];
    if (nloc == 0u) { xcd_barrier_complete(bar, b.x, nloc, nx); b.st[0] = nloc; b.st[1] = nx; }
    const unsigned old = xb_add(&bar[XB_XSUB(b.x)], 1u);
    const unsigned gen = old / nloc;
    if (old + 1u == (gen + 1u) * nloc) {
      __builtin_amdgcn_fence(__ATOMIC_RELEASE, "agent");
      asm volatile("s_waitcnt vmcnt(0)" ::: "memory");
      const unsigned og = xb_add(&bar[XB_TOP], 1u);
      const unsigned tg = og / nx;
      if (og + 1u == (tg + 1u) * nx) xb_add(&bar[XB_TOPGEN], 1u);
      else XB_SPIN(xb_ld(&bar[XB_TOPGEN]) == tg, bar);
      __builtin_amdgcn_fence(__ATOMIC_ACQUIRE, "agent");
      xb_add(&bar[XB_XGEN(b.x)], 1u);
      asm volatile("s_waitcnt vmcnt(0)" ::: "memory");
    } else {
      XB_SPIN(xb_ld(&bar[XB_XGEN(b.x)]) == gen, bar);
      __builtin_amdgcn_fence(__ATOMIC_ACQUIRE, "agent");
      asm volatile("s_waitcnt vmcnt(0)" ::: "memory");
    }
  }
  __syncthreads();
}

__global__ void __launch_bounds__(NTHR) yoco_mega(Params p, int ph_lo, int ph_hi) {
  extern __shared__ __attribute__((aligned(16))) char smem[];
  const int bid = blockIdx.x, nb = gridDim.x;
  const bool fused = (ph_hi - ph_lo) > 1;
  volatile LAS unsigned* st = (volatile LAS unsigned*)(smem + XBST_OFF);
  XcdBarrier xb; xb.bar = p.bar; xb.x = 0; xb.st = st;
  if (fused) {
    if (threadIdx.x == 0) { st[0] = 0u; st[1] = 0u; }
    __syncthreads();
    xb = xcd_barrier_post(p.bar, st);
  }
  if (ph_hi < 0) cg::this_grid().sync();
  for (int pp = ph_lo * 2; pp < ph_hi * 2; ++pp) {
    const int ph = pp >> 1;
    if ((pp & 1) && !((DUP_MASK >> ph) & 1)) continue;
    switch (ph) {
      case 0:
        for (int i = bid; i < 2560; i += nb) prep_wtile(p, i, smem);
        {
          const int rb = (bid * 8 + (tid() >> 6)) * 17;
          for (int r = 0; r < 16; r += 4) prep_xrows<4>(p, rb + r);
          prep_xrows<1>(p, rb + 16);
        }
        break;
      case 1: {
        const bool gB = (bid >> 3) & 1;
        if (gB) { gemm_tile<1, 2>(p, 256 + (bid >> 4), bid & 15, false, -1, 0, smem); __syncthreads(); }
        {
          const int x8 = bid & 7, j8 = bid >> 3, tm0 = (x8 >> 1) * 4 + (j8 >> 3), tnn = (x8 & 1) * 8 + (j8 & 7);
          bool h0 = false;
#pragma unroll 1
          for (int r = 0; r < 8; ++r) { const int ok = r < 7; gemm_tile<1, 4>(p, r * 16 + tm0, tnn, h0, ok ? (r + 1) * 16 + tm0 : -1, tnn, smem); h0 = ok; }
        }
        if (!gB) { __syncthreads(); gemm_tile<1, 2>(p, 256 + (bid >> 4), bid & 15, false, -1, 0, smem); }
      } break;
      case 2: band_phase(p, smem, bid, nb); break;
      case 3: {
        const bool gB = (bid >> 3) & 1;
        const int jb = ((bid >> 4) << 3) | (bid & 7);
        if (gB) { gemm_tile<2, 1>(p, 512 + (jb >> 2), jb & 3, false, -1, 0, smem); __syncthreads(); }
        {
          const int tm0 = (bid & 7) * 8 + (bid >> 5), tnn = (bid >> 3) & 3;
          bool h0 = false;
#pragma unroll 1
          for (int r = 0; r < 4; ++r) { const int ok = r < 3; gemm_tile<2, 2>(p, r * 64 + tm0, tnn, h0, ok ? (r + 1) * 64 + tm0 : -1, tnn, smem); h0 = ok; }
        }
      } break;
      case 4: {
        const bool gB = (bid >> 3) & 1;
        if (gB) { gemm_tile<3, 2>(p, 256 + (bid >> 4), bid & 15, false, -1, 0, smem); __syncthreads(); }
        {
          const int x8 = bid & 7, j8 = bid >> 3, tm0 = (x8 >> 1) * 4 + (j8 >> 3), tnn = (x8 & 1) * 8 + (j8 & 7);
          bool h0 = false;
#pragma unroll 1
          for (int r = 0; r < 8; ++r) { const int ok = r < 7; gemm_tile<3, 4>(p, r * 16 + tm0, tnn, h0, ok ? (r + 1) * 16 + tm0 : -1, tnn, smem); h0 = ok; }
        }
        if (!gB) { __syncthreads(); gemm_tile<3, 2>(p, 256 + (bid >> 4), bid & 15, false, -1, 0, smem); }
      } break;
      case 5: sb_phase(p, smem, bid, nb); break;
      case 6: {
        const bool gB = (bid >> 3) & 1;
        const int jb = ((bid >> 4) << 3) | (bid & 7);
        if (gB) { gemm_tile<4, 1>(p, 512 + (jb >> 2), jb & 3, false, -1, 0, smem); __syncthreads(); }
        {
          const int tm0 = (bid & 7) * 8 + (bid >> 5), tnn = (bid >> 3) & 3;
          bool h0 = false;
#pragma unroll 1
          for (int r = 0; r < 4; ++r) { const int ok = r < 3; gemm_tile<4, 2>(p, r * 64 + tm0, tnn, h0, ok ? (r + 1) * 64 + tm0 : -1, tnn, smem); h0 = ok; }
        }
      } break;
      default: {
        const int rb = (bid * 8 + (tid() >> 6)) * 17;
        for (int r = 0; r < 16; r += 4) final_rows<4>(p, rb + r);
        final_rows<1>(p, rb + 16);
      } break;
    }
    if (pp + 1 < ph_hi * 2) xcd_barrier(xb);
  }
}

extern "C" void kernel_launch(void* const* d_in, const int* in_sizes, int n_in, void* d_out, int out_size,
                              void* d_ws, size_t ws_size, hipStream_t stream) {
  static int grid_blocks = 0;
  if (!grid_blocks) {
    int dev = 0, cus = 0, per_cu = 0;
    hipGetDevice(&dev);
    hipDeviceGetAttribute(&cus, hipDeviceAttributeMultiprocessorCount, dev);
    hipFuncSetAttribute((const void*)yoco_mega, hipFuncAttributeMaxDynamicSharedMemorySize, SMEM_BYTES);
    hipOccupancyMaxActiveBlocksPerMultiprocessor(&per_cu, yoco_mega, NTHR, SMEM_BYTES);
    if (per_cu < 1) per_cu = 1;
    grid_blocks = cus * per_cu;
    if (grid_blocks > 256) grid_blocks = 256;
  }
  Params p{};
  p.x_prompt = (const float*)d_in[0]; p.x_sample = (const float*)d_in[1];
  p.cache_a_k = (const float*)d_in[2]; p.cache_a_v = (const float*)d_in[3];
  p.cache_b_k = (const float*)d_in[4]; p.cache_b_v = (const float*)d_in[5];
  p.norm_a = (const float*)d_in[6]; p.w_in_a = (const float*)d_in[7]; p.rel_bias_a = (const float*)d_in[8];
  p.w_out_a = (const float*)d_in[9]; p.norm_kv = (const float*)d_in[10]; p.w_kv = (const float*)d_in[11];
  p.norm_b = (const float*)d_in[12]; p.w_in_b = (const float*)d_in[13]; p.w_out_b = (const float*)d_in[14];
  p.norm_f = (const float*)d_in[15];
  p.out = (float*)d_out;
  char* ws = (char*)d_ws;
  p.Wa = (bf16*)(ws + WS_WA); p.Woa = (bf16*)(ws + WS_WOA); p.Wb = (bf16*)(ws + WS_WB); p.Wob = (bf16*)(ws + WS_WOB);
  p.xb = (bf16*)(ws + WS_XB); p.qkvg = (bf16*)(ws + WS_QKVG); p.ao = (bf16*)(ws + WS_AO);
  p.x1 = (float*)(ws + WS_X1); p.ss0 = (float*)(ws + WS_SS0); p.ss1 = (float*)(ws + WS_SS1); p.ss2 = (float*)(ws + WS_SS2);
  p.bar = (unsigned*)(ws + WS_BAR);
#if ONE_LAUNCH
  hipMemsetAsync(p.bar, 0, XCD_BAR_WORDS * 4, stream);
  int lo = 0, hi = 8;
  void* args[] = {&p, &lo, &hi};
  hipError_t e = hipLaunchCooperativeKernel((const void*)yoco_mega, dim3(grid_blocks), dim3(NTHR), args, SMEM_BYTES, stream);
  if (e != hipSuccess) fprintf(stderr, "cooperative launch failed: %s (grid %d)\n", hipGetErrorString(e), grid_blocks);
#else
  for (int ph = 0; ph < 8; ++ph)
    hipLaunchKernelGGL(yoco_mega, dim3(grid_blocks), dim3(NTHR), SMEM_BYTES, stream, p, ph, ph + 1);
#endif
}
```
